# Optimizing an MI355X kernel written in HIP

```python
import jax, jax.numpy as jnp
from jax import lax
import numpy as np

D_MODEL = 2048
BATCH = 2
SEQ = 4096
DEPTH = 1

GRID_W = 64
CTX_LEN = 256
SSM_HEADS = 32
SSM_HEAD_DIM = 64
D_SSM = SSM_HEADS * SSM_HEAD_DIM
SSM_GROUPS = 8
D_STATE = 128
CONV_W = 5
CHUNK = 128
D_CONV_CH = D_SSM + 2 * SSM_GROUPS * D_STATE
ATTN_HEADS = 16
KV_HEADS = 4
HEAD_DIM = 128
D_ATTN = ATTN_HEADS * HEAD_DIM
D_KV = KV_HEADS * HEAD_DIM
ROPE_THETA = 10000.0
Q_BLOCK = 128
D_FF = -(-(8 * D_MODEL) // (3 * 256)) * 256
N_MOD = 6
EPS = 1e-6
PROJ_SIZES = (D_SSM, D_CONV_CH, 2 * SSM_HEADS, D_ATTN, D_KV, D_KV, 2 * D_MODEL)
D_IN = sum(PROJ_SIZES)

kernel_name = 'hybrid_ssd_gqa_prefix_dit_block'


def rms(t):
    tf = t.astype(jnp.float32)
    return (tf * lax.rsqrt(jnp.mean(tf * tf, axis=-1, keepdims=True) + EPS)).astype(t.dtype)


def modulate(h, shift, scale):
    return h * (1 + scale) + shift


def split_proj(p):
    idx = np.cumsum(PROJ_SIZES)[:-1].tolist()
    return jnp.split(p, idx, axis=-1)


def axial_rope_tables(rows, cols):
    n_freq = HEAD_DIM // 4
    inv = jnp.power(ROPE_THETA, -jnp.arange(n_freq, dtype=jnp.float32) / n_freq)
    ang = jnp.stack([rows.astype(jnp.float32)[:, None] * inv,
                     cols.astype(jnp.float32)[:, None] * inv], axis=1)
    return jnp.cos(ang), jnp.sin(ang)


def apply_rope(t, cos, sin):
    b, s, h, d = t.shape
    tr = t.reshape(b, s, h, 2, 2, d // 4)
    t1, t2 = tr[..., 0, :], tr[..., 1, :]
    cs = cos[None, :, None].astype(t.dtype)
    sn = sin[None, :, None].astype(t.dtype)
    return jnp.stack([t1 * cs - t2 * sn, t2 * cs + t1 * sn], axis=-2).reshape(b, s, h, d)


def dwconv(u, w, bias):
    pad = (CONV_W - 1) // 2
    out = lax.conv_general_dilated(u, w[:, None, :].astype(u.dtype), window_strides=(1,),
                                   padding=[(pad, pad)], dimension_numbers=('NWC', 'WIO', 'NWC'),
                                   feature_group_count=u.shape[-1])
    return out + bias.astype(u.dtype)


def ssd_prep(xbc, dt_raw, conv_w, conv_b, dt_bias):
    b, l, _ = xbc.shape
    xbc = jax.nn.silu(dwconv(xbc, conv_w, conv_b))
    gn = SSM_GROUPS * D_STATE
    xs = xbc[..., :D_SSM].reshape(b, l, SSM_HEADS, SSM_HEAD_DIM)
    bm = xbc[..., D_SSM:D_SSM + gn].reshape(b, l, SSM_GROUPS, D_STATE)
    cm = xbc[..., D_SSM + gn:].reshape(b, l, SSM_GROUPS, D_STATE)
    dt = jax.nn.softplus(dt_raw.reshape(b, l, 2, SSM_HEADS).astype(jnp.float32)
                         + dt_bias.astype(jnp.float32))
    return xs, bm, cm, dt


def ssd_scan(xs, dt, a_neg, bm, cm, h0):
    b, l, h, p = xs.shape
    g, n = bm.shape[2], bm.shape[3]
    nc = l // CHUNK
    f32 = jnp.float32
    rep = h // g
    bh = jnp.repeat(bm.astype(f32), rep, axis=2).reshape(b, nc, CHUNK, h, n)
    ch = jnp.repeat(cm.astype(f32), rep, axis=2).reshape(b, nc, CHUNK, h, n)
    xdt = (xs.astype(f32) * dt[..., None]).reshape(b, nc, CHUNK, h, p)
    a = (dt * a_neg).reshape(b, nc, CHUNK, h).transpose(0, 3, 1, 2)
    a_cum = jnp.cumsum(a, axis=-1)
    lower = jnp.tril(jnp.ones((CHUNK, CHUNK), dtype=bool))
    seg = jnp.exp(jnp.where(lower, a_cum[..., :, None] - a_cum[..., None, :], -jnp.inf))
    scores = jnp.einsum('bclhn,bcshn->bhcls', ch, bh) * seg
    y_diag = jnp.einsum('bhcls,bcshp->bclhp', scores, xdt)
    decay_to_end = jnp.exp(a_cum[..., -1:] - a_cum)
    chunk_states = jnp.einsum('bclhn,bhcl,bclhp->bchpn', bh, decay_to_end, xdt)
    chunk_decay = jnp.exp(a_cum[..., -1])

    def step(state, inp):
        dec, st = inp
        return dec[:, :, None, None] * state + st, state

    h_final, h_prev = lax.scan(step, h0.astype(f32),
                               (chunk_decay.transpose(2, 0, 1), chunk_states.transpose(1, 0, 2, 3, 4)))
    y_off = jnp.einsum('bclhn,cbhpn,bhcl->bclhp', ch, h_prev, jnp.exp(a_cum))
    return (y_diag + y_off).reshape(b, l, h, p), h_final


def bi_ssd(xs, bm, cm, dt, a_log, d_skip, h0_fwd, h0_bwd):
    a_neg = -jnp.exp(a_log.astype(jnp.float32))
    y_f, h_f = ssd_scan(xs, dt[:, :, 0], a_neg[0], bm, cm, h0_fwd)
    rev = lambda t: jnp.flip(t, axis=1)
    y_b, h_b = ssd_scan(rev(xs), rev(dt[:, :, 1]), a_neg[1], rev(bm), rev(cm), h0_bwd)
    y = y_f + rev(y_b) + d_skip.astype(jnp.float32)[:, None] * xs.astype(jnp.float32)
    return y.astype(xs.dtype), h_f, h_b


def ssm_output(y, z, norm_g):
    b, l = z.shape[:2]
    gsz = D_SSM // SSM_GROUPS
    gated = y.reshape(b, l, SSM_GROUPS, gsz) * jax.nn.silu(z).reshape(b, l, SSM_GROUPS, gsz)
    return rms(gated).reshape(b, l, D_SSM) * norm_g


def attend_blocks(q, keys, vals):
    b, s = q.shape[:2]
    nb = s // Q_BLOCK
    rep = ATTN_HEADS // KV_HEADS
    qb = q.reshape(b, nb, Q_BLOCK, KV_HEADS, rep, HEAD_DIM).transpose(1, 0, 2, 3, 4, 5)
    scale = HEAD_DIM ** -0.5

    def one_block(qi):
        sc = jnp.einsum('bqgrd,bkgd->bgrqk', qi, keys).astype(jnp.float32) * scale
        pr = jax.nn.softmax(sc, axis=-1).astype(vals.dtype)
        return jnp.einsum('bgrqk,bkgd->bqgrd', pr, vals)

    out = lax.map(one_block, qb)
    return out.transpose(1, 0, 2, 3, 4, 5).reshape(b, s, D_ATTN)


def branch_merge(gates, ssm_br, attn_br):
    g_ssm, g_attn = jnp.split(gates, 2, axis=-1)
    return jax.nn.sigmoid(g_ssm) * ssm_br + jax.nn.sigmoid(g_attn) * attn_br


def swiglu(h, w_in, w_out):
    gate, up = jnp.split(h @ w_in, 2, axis=-1)
    return (jax.nn.silu(gate) * up) @ w_out


def setup_inputs(seed: int = 0) -> dict:
    key = jax.random.key(seed)
    ks = jax.random.split(key, 24)
    f32 = jnp.float32

    def nrm(k, shape, fan_in, gain=1.0):
        return jax.random.normal(k, shape, f32) * (gain * fan_in ** -0.5)

    dt0 = jnp.exp(jax.random.uniform(ks[9], (DEPTH, 2, SSM_HEADS), f32,
                                     minval=float(np.log(1e-3)), maxval=float(np.log(1e-1))))
    dt_bias = dt0 + jnp.log(-jnp.expm1(-dt0))
    a_log = jnp.log(jax.random.uniform(ks[10], (DEPTH, 2, SSM_HEADS), f32, minval=1.0, maxval=16.0))
    return {
        'x': jax.random.normal(ks[0], (BATCH, SEQ, D_MODEL), f32),
        'c': jax.random.normal(ks[1], (BATCH, D_MODEL), f32),
        'ctx': jax.random.normal(ks[2], (BATCH, CTX_LEN, D_MODEL), f32),
        'c_ctx': jax.random.normal(ks[3], (D_MODEL,), f32),
        'w_mod': nrm(ks[4], (DEPTH, D_MODEL, N_MOD * D_MODEL), D_MODEL, 0.5),
        'b_mod': 0.02 * jax.random.normal(ks[5], (DEPTH, N_MOD * D_MODEL), f32),
        'norm1': 1.0 + 0.05 * jax.random.normal(ks[6], (DEPTH, D_MODEL), f32),
        'w_in': nrm(ks[7], (DEPTH, D_MODEL, D_IN), D_MODEL),
        'conv_w': nrm(ks[8], (DEPTH, CONV_W, D_CONV_CH), CONV_W),
        'conv_b': 0.02 * jax.random.normal(ks[11], (DEPTH, D_CONV_CH), f32),
        'dt_bias': dt_bias,
        'a_log': a_log,
        'd_skip': 1.0 + 0.1 * jax.random.normal(ks[12], (DEPTH, SSM_HEADS), f32),
        'ssm_norm': 1.0 + 0.05 * jax.random.normal(ks[13], (DEPTH, D_SSM), f32),
        'q_norm': 1.0 + 0.05 * jax.random.normal(ks[14], (DEPTH, HEAD_DIM), f32),
        'k_norm': 1.0 + 0.05 * jax.random.normal(ks[15], (DEPTH, HEAD_DIM), f32),
        'w_ssm_br': nrm(ks[16], (DEPTH, D_SSM, D_MODEL), D_SSM),
        'w_attn_br': nrm(ks[17], (DEPTH, D_ATTN, D_MODEL), D_ATTN),
        'w_o': nrm(ks[18], (DEPTH, D_MODEL, D_MODEL), D_MODEL),
        'norm2': 1.0 + 0.05 * jax.random.normal(ks[19], (DEPTH, D_MODEL), f32),
        'w_ffn_in': nrm(ks[20], (DEPTH, D_MODEL, 2 * D_FF), D_MODEL),
        'w_ffn_out': nrm(ks[21], (DEPTH, D_FF, D_MODEL), D_FF),
    }


def reference(x, c, ctx, c_ctx, w_mod, b_mod, norm1, w_in, conv_w, conv_b, dt_bias, a_log, d_skip,
              ssm_norm, q_norm, k_norm, w_ssm_br, w_attn_br, w_o, norm2, w_ffn_in, w_ffn_out):
    b, s, _ = x.shape
    n_ctx = ctx.shape[1]
    rows_n = s // GRID_W
    rows = jnp.repeat(jnp.arange(rows_n), GRID_W)
    cols = jnp.tile(jnp.arange(GRID_W), rows_n)
    cos, sin = axial_rope_tables(rows, cols)
    h0 = jnp.zeros((b, SSM_HEADS, SSM_HEAD_DIM, D_STATE), jnp.float32)

    for i in range(DEPTH):
        sh1, sc1, gt1, sh2, sc2, gt2 = [m[:, None, :] for m in
                                        jnp.split(jax.nn.silu(c) @ w_mod[i] + b_mod[i], N_MOD, axis=-1)]
        csh1, csc1, cgt1, csh2, csc2, cgt2 = [m[None, None, :] for m in
                                              jnp.split(jax.nn.silu(c_ctx) @ w_mod[i] + b_mod[i], N_MOD, axis=-1)]
        z_l, xbc_l, dtr_l, q_l, k_l, v_l, g_l = split_proj(modulate(rms(x) * norm1[i], sh1, sc1) @ w_in[i])
        z_c, xbc_c, dtr_c, q_c, k_c, v_c, g_c = split_proj(modulate(rms(ctx) * norm1[i], csh1, csc1) @ w_in[i])

        xs_c, bm_c, cm_c, dt_c = ssd_prep(xbc_c, dtr_c, conv_w[i], conv_b[i], dt_bias[i])
        xs_l, bm_l, cm_l, dt_l = ssd_prep(xbc_l, dtr_l, conv_w[i], conv_b[i], dt_bias[i])
        y_c, hf_c, hb_c = bi_ssd(xs_c, bm_c, cm_c, dt_c, a_log[i], d_skip[i], h0, h0)
        y_l, _, _ = bi_ssd(xs_l, bm_l, cm_l, dt_l, a_log[i], d_skip[i], hf_c, hb_c)
        ssm_br_l = ssm_output(y_l, z_l, ssm_norm[i]) @ w_ssm_br[i]

        ck = rms(k_c.reshape(b, n_ctx, KV_HEADS, HEAD_DIM)) * k_norm[i]
        cv = v_c.reshape(b, n_ctx, KV_HEADS, HEAD_DIM)
        ql = apply_rope(rms(q_l.reshape(b, s, ATTN_HEADS, HEAD_DIM)) * q_norm[i], cos, sin)
        kl = apply_rope(rms(k_l.reshape(b, s, KV_HEADS, HEAD_DIM)) * k_norm[i], cos, sin)
        vl = v_l.reshape(b, s, KV_HEADS, HEAD_DIM)
        keys = jnp.concatenate([ck, kl], axis=1)
        vals = jnp.concatenate([cv, vl], axis=1)
        attn_br_l = attend_blocks(ql, keys, vals) @ w_attn_br[i]

        x_mid = x + gt1 * (branch_merge(g_l, ssm_br_l, attn_br_l) @ w_o[i])
        x_new = x_mid + gt2 * swiglu(modulate(rms(x_mid) * norm2[i], sh2, sc2), w_ffn_in[i], w_ffn_out[i])

        if i < DEPTH - 1:
            ssm_br_c = ssm_output(y_c, z_c, ssm_norm[i]) @ w_ssm_br[i]
            qc = rms(q_c.reshape(b, n_ctx, ATTN_HEADS, HEAD_DIM)) * q_norm[i]
            attn_br_c = attend_blocks(qc, ck, cv) @ w_attn_br[i]
            ctx_mid = ctx + cgt1 * (branch_merge(g_c, ssm_br_c, attn_br_c) @ w_o[i])
            ctx = ctx_mid + cgt2 * swiglu(modulate(rms(ctx_mid) * norm2[i], csh2, csc2),
                                          w_ffn_in[i], w_ffn_out[i])
        x = x_new
    return x
```

```cpp
#include <hip/hip_runtime.h>
#include <hip/hip_cooperative_groups.h>
#include <cstdio>
#include <cstdint>
namespace cg = cooperative_groups;

#define DI __device__ __forceinline__
#define LAS __attribute__((address_space(3)))
typedef unsigned short bf16_t;
typedef short bf16x8 __attribute__((ext_vector_type(8)));
typedef short s16x4 __attribute__((ext_vector_type(4)));
typedef float f32x2 __attribute__((ext_vector_type(2)));
typedef float f32x4 __attribute__((ext_vector_type(4)));
typedef float f32x16 __attribute__((ext_vector_type(16)));
typedef unsigned u32x2 __attribute__((ext_vector_type(2)));
typedef unsigned u32x4 __attribute__((ext_vector_type(4)));

constexpr int DM = 2048, NB = 2, SEQ = 4096, CTXL = 256, RPB = SEQ + CTXL  , MP = NB * RPB  , ML = NB * SEQ;
constexpr int LDP = 13568;
constexpr int C_Z = 0, C_XBC = 2048, C_Q = 6144, C_K = 8192, C_V = 8704, C_G = 9216, C_DT = 13312;
constexpr int DFF = 5632, NMOD = 12288, NSLOT = 34;
constexpr float EPS = 1e-6f;
constexpr int NTHR = 512, NWAVES = 8;
constexpr int LDS_BYTES = 144 * 1024;

constexpr size_t al256(size_t x) { return (x + 255) / 256 * 256; }
constexpr size_t WS_CTL = 0;
constexpr size_t WS_MOD = 4096;
constexpr size_t ZERO_BYTES = WS_MOD + (size_t)3 * NMOD * 4;
constexpr size_t WS_DT  = al256(ZERO_BYTES);
constexpr size_t WS_DEC = al256(WS_DT + (size_t)MP * 64 * 4);
constexpr size_t WS_R1  = al256(WS_DEC + (size_t)NB * 2 * NSLOT * 32 * 4);
constexpr size_t SZ_WIN = (size_t)LDP * DM * 2;
constexpr size_t WS_WIN = WS_R1;
constexpr size_t WS_XN  = WS_R1 + SZ_WIN;
constexpr size_t SZ_R1  = SZ_WIN + (size_t)MP * DM * 2;
constexpr size_t WS_XBC = WS_R1;
constexpr size_t WS_XN2 = WS_R1;
constexpr size_t WS_R2  = al256(WS_R1 + SZ_R1);
constexpr size_t WS_WSSM = WS_R2, WS_WATT = WS_R2 + (size_t)DM * DM * 2, WS_WO = WS_R2 + (size_t)2 * DM * DM * 2;
constexpr size_t WS_R3  = al256(WS_R2 + (size_t)3 * DM * DM * 2);
constexpr size_t WS_P   = WS_R3;
constexpr size_t WS_HID = WS_R3;
constexpr size_t WS_R4  = al256(WS_R3 + (size_t)MP * LDP * 2);
constexpr size_t PLANE  = (size_t)32 * 64 * 128;
constexpr size_t WS_ST  = WS_R4;
constexpr size_t WS_WF1 = WS_R4;
constexpr size_t WS_WF2 = WS_R4 + (size_t)2 * DFF * DM * 2;
constexpr size_t WS_END = al256(WS_R4 + (size_t)NB * 2 * NSLOT * PLANE * 2);
static_assert((size_t)2 * DFF * DM * 2 + (size_t)DM * DFF * 2 <= (size_t)NB * 2 * NSLOT * PLANE * 2, "ffn weights fit the state region");
static_assert((size_t)MP * 4096 * 2 <= SZ_R1, "xbc fits r1");

DI unsigned cvt_pk_bf16(float lo, float hi) { unsigned r; asm volatile("v_cvt_pk_bf16_f32 %0, %1, %2" : "=v"(r) : "v"(lo), "v"(hi)); return r; }
DI float bflo(unsigned w) { return __uint_as_float(w << 16); }
DI float bfhi(unsigned w) { return __uint_as_float(w & 0xffff0000u); }
DI float bf2f(bf16_t b) { return __uint_as_float(((unsigned)b) << 16); }
DI bf16_t f2bf(float x) { return (bf16_t)(cvt_pk_bf16(x, 0.f) & 0xffffu); }
DI float wave_sum(float v) { for (int o = 32; o >= 1; o >>= 1) v += __shfl_xor(v, o); return v; }
DI float sigmoidf_(float x) { return 1.f / (1.f + __expf(-x)); }
DI float siluf_(float x) { return x / (1.f + __expf(-x)); }
DI float softplusf_(float x) { return fmaxf(x, 0.f) + log1pf(__expf(-fabsf(x))); }

namespace pg8 {
constexpr int BM = 256, BK = 64, HALF = 128, HTB = HALF * BK * 2, STAGE_BYTES = 8 * HTB, NXCD = 8, WGM = 8;
DI int lds_byte(int r, int c) { const int st = (r >> 4) * 2 + (c >> 5), rr = r & 15, cc = c & 31, ob = rr * 64 + cc * 2; return st * 1024 + (ob ^ (((ob >> 9) & 1) << 5)); }
DI void stage_rc(int b, int& R, int& C) { const int st = b / 1024, sb = b % 1024, swz = sb ^ (((sb >> 9) & 1) << 5); R = (st >> 1) * 16 + swz / 64; C = (st & 1) * 32 + (swz % 64) / 2; }
DI int perm32(int rho) { const int n = rho >> 4, i = rho & 15; return 8 * (i >> 2) + 4 * n + (i & 3); }
struct Unit { int pm, pn; };
struct Gemm { const bf16_t* A; const bf16_t* Bt; int lda, ldb, K; };
struct Sched {
    int nM, nN, nwg, G, c, mode, total;
    DI void init(int nM_, int nN_, int G_, int c_, int mode_) { nM = nM_; nN = nN_; nwg = nM * nN; G = G_; c = c_; mode = mode_; total = nwg + (mode == 2 ? 42 : 0); }
    DI bool next(int i, Unit& u) const {
        const int L = i * G + c; if (L >= total) return false;
        if (L >= nwg) { const int j = L - nwg, t = j / 21, q = j % 21; u.pm = t * 17; u.pn = q < 16 ? 8 + q : (q < 20 ? 32 + (q - 16) : 52); return true; }
        int wgid = L; { const int q = nwg / NXCD, r = nwg % NXCD, xcd = wgid % NXCD, off = wgid / NXCD; wgid = (xcd < r ? xcd * (q + 1) : r * (q + 1) + (xcd - r) * q) + off; }
        const int nig = WGM * nN, gid = wgid / nig, fm = gid * WGM, gsz = (nM - fm) < WGM ? (nM - fm) : WGM;
        int pm = fm + ((wgid % nig) % gsz); const int pn = (wgid % nig) / gsz;
        if (mode) pm = pm + 1 + (pm >= 16 ? 1 : 0);
        u.pm = pm; u.pn = pn; return true;
    }
};

template <class Epi>
DI void gemm_phase(LAS unsigned char* lds, const Gemm g, const Sched& S, const Epi& E) {
    int tid = threadIdx.x; asm volatile("" : "+v"(tid));
    const int wid = __builtin_amdgcn_readfirstlane(tid >> 6), lane = tid & 63, wr = wid >> 2, wc = wid & 3, fr = lane & 15, fq = lane >> 4;
    const int K = g.K, nt = K / BK;
    unsigned voffA[2], voffB[2];
#pragma unroll
    for (int i = 0; i < 2; ++i) { int R, C; stage_rc(tid * 16 + i * 8192, R, C); const int Rb = Epi::PERM ? ((R & ~31) + perm32(R & 31)) : R;
        voffA[i] = (unsigned)(R * g.lda + C) * 2u; voffB[i] = (unsigned)(Rb * g.ldb + C) * 2u; }
    const size_t kstep = (size_t)(BK * 2);
    const size_t hstepA = (size_t)HALF * g.lda * 2, hstepB = (size_t)HALF * g.ldb * 2;
    const size_t tstepA = 2 * hstepA, tstepB = 2 * hstepB;
    const unsigned ldsw = (unsigned)wid * 1024u;
    const int aoff = lds_byte(wr * 64 + fr, fq * 8), boff = lds_byte(wc * 32 + fr, fq * 8);
#define PG8_SA(b, h) (((b) * 2 + (h)) * HTB)
#define PG8_SB(b, h) ((4 + (b) * 2 + (h)) * HTB)
#define PG8_STAGE(bufoff, gbase, voff) do { _Pragma("unroll") for (int _i = 0; _i < 2; ++_i) \
        __builtin_amdgcn_global_load_lds((const unsigned*)((const char*)(gbase) + (voff)[_i]), (LAS unsigned*)(lds + (bufoff) + ldsw + _i * 8192), 16, 0, 0); } while (0)
#define PG8_LDA(dst, b, h) do { _Pragma("unroll") for (int m = 0; m < 4; ++m) _Pragma("unroll") for (int k = 0; k < 2; ++k) dst[m][k] = *(const LAS bf16x8*)(lds + PG8_SA(b, h) + aoff + m * 2048 + k * 1024); } while (0)
#define PG8_LDB(dst, b, h) do { _Pragma("unroll") for (int n = 0; n < 2; ++n) _Pragma("unroll") for (int k = 0; k < 2; ++k) dst[n][k] = *(const LAS bf16x8*)(lds + PG8_SB(b, h) + boff + n * 2048 + k * 1024); } while (0)
#define PG8_MMA(ai, bj, At, Bt) do { __builtin_amdgcn_s_setprio(1); _Pragma("unroll") for (int m = 0; m < 4; ++m) _Pragma("unroll") for (int n = 0; n < 2; ++n) _Pragma("unroll") for (int k = 0; k < 2; ++k) \
        acc[ai][bj][m][n] = __builtin_amdgcn_mfma_f32_16x16x32_bf16(Bt[n][k], At[m][k], acc[ai][bj][m][n], 0, 0, 0); __builtin_amdgcn_s_setprio(0); } while (0)
#define PG8_WAIT_V(n) asm volatile("s_waitcnt vmcnt(" #n ")" ::: "memory")
#define PG8_WAIT_L(n) asm volatile("s_waitcnt lgkmcnt(" #n ")" ::: "memory")
#define PG8_BAR __builtin_amdgcn_s_barrier()
#define PG8_SCHED __builtin_amdgcn_sched_barrier(0)
    Unit cur, nxt; int ui = 0;
    if (!S.next(0, cur)) return;
    f32x4 acc[2][2][4][2];
#pragma unroll
    for (int a = 0; a < 2; ++a)
#pragma unroll
        for (int b = 0; b < 2; ++b)
#pragma unroll
            for (int m = 0; m < 4; ++m)
#pragma unroll
                for (int n = 0; n < 2; ++n) acc[a][b][m][n] = (f32x4){0.f, 0.f, 0.f, 0.f};
    bf16x8 At[4][2], B0[2][2], B1[2][2];
    const char* cA = (const char*)g.A + (size_t)cur.pm * tstepA; const char* cB = (const char*)g.Bt + (size_t)cur.pn * tstepB;
    PG8_STAGE(PG8_SB(0, 0), cB, voffB); PG8_STAGE(PG8_SA(0, 0), cA, voffA); PG8_STAGE(PG8_SB(0, 1), cB + hstepB, voffB); PG8_STAGE(PG8_SA(0, 1), cA + hstepA, voffA);
    if (wr == 1) PG8_BAR;
    PG8_WAIT_V(4); PG8_BAR;
    PG8_STAGE(PG8_SB(1, 0), cB + kstep, voffB); PG8_STAGE(PG8_SA(1, 0), cA + kstep, voffA); PG8_STAGE(PG8_SB(1, 1), cB + hstepB + kstep, voffB);
    PG8_WAIT_V(6); PG8_BAR;
    for (;;) {
        const bool has_next = S.next(ui + 1, nxt);
        const char* nA = has_next ? (const char*)g.A + (size_t)nxt.pm * tstepA : cA; const char* nB = has_next ? (const char*)g.Bt + (size_t)nxt.pn * tstepB : cB;
        for (int t = 0; t < nt; t += 2) {
            const bool last = (t == nt - 2);
            const char* a1 = cA + (size_t)(t + 1) * kstep;
            const char* a2 = last ? nA : cA + (size_t)(t + 2) * kstep; const char* b2 = last ? nB : cB + (size_t)(t + 2) * kstep;
            const char* a3 = a2 + kstep; const char* b3 = b2 + kstep;
            PG8_LDB(B0, 0, 0); PG8_SCHED; PG8_LDA(At, 0, 0); PG8_STAGE(PG8_SA(1, 1), a1 + hstepA, voffA);
            PG8_WAIT_L(8); PG8_BAR; PG8_WAIT_L(0); PG8_MMA(0, 0, At, B0); PG8_BAR; PG8_SCHED;
            PG8_LDB(B1, 0, 1); PG8_STAGE(PG8_SB(0, 0), b2, voffB);
            PG8_BAR; PG8_WAIT_L(0); PG8_MMA(0, 1, At, B1); PG8_BAR;
            PG8_LDA(At, 0, 1); PG8_STAGE(PG8_SA(0, 0), a2, voffA);
            PG8_BAR; PG8_WAIT_L(0); PG8_MMA(1, 0, At, B0); PG8_BAR; PG8_SCHED;
            PG8_STAGE(PG8_SB(0, 1), b2 + hstepB, voffB);
            PG8_WAIT_V(6); PG8_BAR; PG8_MMA(1, 1, At, B1); PG8_BAR;
            PG8_LDB(B0, 1, 0); PG8_SCHED; PG8_LDA(At, 1, 0); PG8_STAGE(PG8_SA(0, 1), a2 + hstepA, voffA);
            PG8_WAIT_L(8); PG8_BAR; PG8_WAIT_L(0); PG8_MMA(0, 0, At, B0); PG8_BAR; PG8_SCHED;
            PG8_LDB(B1, 1, 1); PG8_STAGE(PG8_SB(1, 0), b3, voffB);
            PG8_BAR; PG8_WAIT_L(0); PG8_MMA(0, 1, At, B1); PG8_BAR;
            PG8_LDA(At, 1, 1); PG8_STAGE(PG8_SA(1, 0), a3, voffA);
            PG8_BAR; PG8_WAIT_L(0); PG8_MMA(1, 0, At, B0); PG8_BAR; PG8_SCHED;
            PG8_STAGE(PG8_SB(1, 1), b3 + hstepB, voffB);
            PG8_WAIT_V(6); PG8_BAR; PG8_MMA(1, 1, At, B1); PG8_BAR;
        }
        E(acc, cur, wr, wc, fr, fq);
        if (!has_next) break;
#pragma unroll
        for (int a = 0; a < 2; ++a)
#pragma unroll
            for (int b = 0; b < 2; ++b)
#pragma unroll
                for (int m = 0; m < 4; ++m)
#pragma unroll
                    for (int n = 0; n < 2; ++n) acc[a][b][m][n] = (f32x4){0.f, 0.f, 0.f, 0.f};
        cur = nxt; cA = nA; cB = nB; ++ui;
    }
    PG8_WAIT_V(0);
    if (wr == 0) PG8_BAR;
    PG8_BAR;
#undef PG8_SA
#undef PG8_SB
#undef PG8_STAGE
#undef PG8_LDA
#undef PG8_LDB
#undef PG8_MMA
#undef PG8_WAIT_V
#undef PG8_WAIT_L
#undef PG8_BAR
#undef PG8_SCHED
}

struct EpiInProj {
    static constexpr bool PERM = true;
    bf16_t* P; float* DT; const float* dt_bias;
    DI void operator()(const f32x4 (&acc)[2][2][4][2], const Unit& u, int wr, int wc, int fr, int fq) const {
        const int row0 = u.pm * BM + wr * 64 + fr;
        if (u.pn < 52) {
            const int col0 = u.pn * BM + wc * 32 + 8 * fq;
#pragma unroll
            for (int ai = 0; ai < 2; ++ai)
#pragma unroll
                for (int m = 0; m < 4; ++m) { bf16_t* rowp = P + (size_t)(row0 + ai * HALF + m * 16) * LDP + col0;
#pragma unroll
                    for (int bj = 0; bj < 2; ++bj) { const f32x4 v0 = acc[ai][bj][m][0], v1 = acc[ai][bj][m][1];
                        u32x4 w; w.x = cvt_pk_bf16(v0[0], v0[1]); w.y = cvt_pk_bf16(v0[2], v0[3]); w.z = cvt_pk_bf16(v1[0], v1[1]); w.w = cvt_pk_bf16(v1[2], v1[3]);
                        *(u32x4*)(rowp + bj * HALF) = w; } }
        } else if (wc < 2) {
            const int c0 = wc * 32 + 8 * fq;
#pragma unroll
            for (int ai = 0; ai < 2; ++ai)
#pragma unroll
                for (int m = 0; m < 4; ++m) { float* rowp = DT + (size_t)(row0 + ai * HALF + m * 16) * 64 + c0;
#pragma unroll
                    for (int n = 0; n < 2; ++n) { f32x4 v = acc[ai][0][m][n];
#pragma unroll
                        for (int j = 0; j < 4; ++j) v[j] = softplusf_(v[j] + dt_bias[c0 + 4 * n + j]);
                        *(f32x4*)(rowp + 4 * n) = v; } }
        }
    }
};
template <int SECOND> struct EpiBranch {
    static constexpr bool PERM = true;
    bf16_t* P;
    DI void operator()(const f32x4 (&acc)[2][2][4][2], const Unit& u, int wr, int wc, int fr, int fq) const {
        const int row0 = u.pm * BM + wr * 64 + fr, col0 = C_G + u.pn * BM + wc * 32 + 8 * fq;
#pragma unroll
        for (int ai = 0; ai < 2; ++ai)
#pragma unroll
            for (int m = 0; m < 4; ++m) { bf16_t* rowp = P + (size_t)(row0 + ai * HALF + m * 16) * LDP + col0;
#pragma unroll
                for (int bj = 0; bj < 2; ++bj) { const f32x4 v0 = acc[ai][bj][m][0], v1 = acc[ai][bj][m][1];
                    const u32x4 gw = *(const u32x4*)(rowp + bj * HALF + (SECOND ? DM : 0));
                    float r[8];
                    r[0] = sigmoidf_(bflo(gw.x)) * v0[0]; r[1] = sigmoidf_(bfhi(gw.x)) * v0[1]; r[2] = sigmoidf_(bflo(gw.y)) * v0[2]; r[3] = sigmoidf_(bfhi(gw.y)) * v0[3];
                    r[4] = sigmoidf_(bflo(gw.z)) * v1[0]; r[5] = sigmoidf_(bfhi(gw.z)) * v1[1]; r[6] = sigmoidf_(bflo(gw.w)) * v1[2]; r[7] = sigmoidf_(bfhi(gw.w)) * v1[3];
                    if (SECOND) { const u32x4 pw = *(const u32x4*)(rowp + bj * HALF);
                        r[0] += bflo(pw.x); r[1] += bfhi(pw.x); r[2] += bflo(pw.y); r[3] += bfhi(pw.y); r[4] += bflo(pw.z); r[5] += bfhi(pw.z); r[6] += bflo(pw.w); r[7] += bfhi(pw.w); }
                    u32x4 w; w.x = cvt_pk_bf16(r[0], r[1]); w.y = cvt_pk_bf16(r[2], r[3]); w.z = cvt_pk_bf16(r[4], r[5]); w.w = cvt_pk_bf16(r[6], r[7]);
                    *(u32x4*)(rowp + bj * HALF) = w; } }
    }
};
template <int INP> struct EpiResid {
    static constexpr bool PERM = false;
    const float* base; float* out; const float* mod; const float* b_mod; int goff;
    DI void operator()(const f32x4 (&acc)[2][2][4][2], const Unit& u, int wr, int wc, int fr, int fq) const {
        const int b = INP ? (u.pm >= 16 ? 1 : 0) : (u.pm >= 17 ? 1 : 0);
        const int lat0 = (INP ? u.pm * BM : u.pm * BM - 256 * (b + 1)) + wr * 64 + fr, col0 = u.pn * BM + wc * 32 + 4 * fq;
        f32x4 gv[2][2];
#pragma unroll
        for (int bj = 0; bj < 2; ++bj)
#pragma unroll
            for (int n = 0; n < 2; ++n) gv[bj][n] = *(const f32x4*)(mod + (size_t)b * NMOD + goff + col0 + bj * HALF + n * 16) + *(const f32x4*)(b_mod + goff + col0 + bj * HALF + n * 16);
#pragma unroll
        for (int ai = 0; ai < 2; ++ai)
#pragma unroll
            for (int m = 0; m < 4; ++m) { const size_t off = (size_t)(lat0 + ai * HALF + m * 16) * DM + col0;
#pragma unroll
                for (int bj = 0; bj < 2; ++bj)
#pragma unroll
                    for (int n = 0; n < 2; ++n) { const f32x4 bs = *(const f32x4*)(base + off + bj * HALF + n * 16);
                        *(f32x4*)(out + off + bj * HALF + n * 16) = bs + gv[bj][n] * acc[ai][bj][m][n]; }
                asm volatile("" ::: "memory"); }
    }
};
struct EpiSwiglu {
    static constexpr bool PERM = true;
    bf16_t* H;
    DI void operator()(const f32x4 (&acc)[2][2][4][2], const Unit& u, int wr, int wc, int fr, int fq) const {
        const int row0 = u.pm * BM + wr * 64 + fr, col0 = u.pn * HALF + wc * 32 + 8 * fq;
#pragma unroll
        for (int ai = 0; ai < 2; ++ai)
#pragma unroll
            for (int m = 0; m < 4; ++m) { bf16_t* rowp = H + (size_t)(row0 + ai * HALF + m * 16) * DFF + col0;
                const f32x4 g0 = acc[ai][0][m][0], g1 = acc[ai][0][m][1], u0 = acc[ai][1][m][0], u1 = acc[ai][1][m][1];
                u32x4 w; w.x = cvt_pk_bf16(siluf_(g0[0]) * u0[0], siluf_(g0[1]) * u0[1]); w.y = cvt_pk_bf16(siluf_(g0[2]) * u0[2], siluf_(g0[3]) * u0[3]);
                w.z = cvt_pk_bf16(siluf_(g1[0]) * u1[0], siluf_(g1[1]) * u1[1]); w.w = cvt_pk_bf16(siluf_(g1[2]) * u1[2], siluf_(g1[3]) * u1[3]);
                *(u32x4*)rowp = w; }
    }
};
}

namespace att {
constexpr int D = 128, NW = 8, QBLK = 32, KVBLK = 64;
constexpr float SCALE = 0.088388347648318440f;
constexpr float THR = 8.f;
constexpr int LDQ = LDP, LDK = LDP, LDO = LDP;
constexpr size_t SHM_V = KVBLK * D * 2, SHM_K = KVBLK * D * 2, SHM_ATTN = 2 * SHM_V + 2 * SHM_K + NW * 64 * 4;
#define KSWZ(row, colB) ((row) * 256 + ((colB) ^ (((row) & 7) << 4)))
#define SBAR() __builtin_amdgcn_sched_barrier(0)
DI int crow(int r, int hi) { return (r & 3) + 8 * (r >> 2) + 4 * hi; }
DI unsigned cvtpk(float lo, float hi) { unsigned r; asm volatile("v_cvt_pk_bf16_f32 %0, %1, %2" : "=v"(r) : "v"(lo), "v"(hi)); return r; }
DI bf16x8 ld8(const bf16_t* p) { return *reinterpret_cast<const bf16x8*>(p); }
DI void partialSM(f32x16& p0, f32x16& p1, float& m_reg, float& mn, float& alpha) {
  constexpr float C = SCALE * 1.4426950408889634f;
  float pmax = p0[0]; for (int r = 1; r < 16; ++r) pmax = fmaxf(pmax, p0[r]); for (int r = 0; r < 16; ++r) pmax = fmaxf(pmax, p1[r]);
  { auto rr = __builtin_amdgcn_permlane32_swap(__float_as_uint(pmax), __float_as_uint(pmax), false, false);
    pmax = fmaxf(__uint_as_float(rr[0]), __uint_as_float(rr[1])); }
  if (__builtin_expect(__all(pmax - m_reg <= THR / SCALE), 1)) { mn = m_reg; alpha = 1.f; }
  else { mn = fmaxf(m_reg, pmax); alpha = __builtin_amdgcn_exp2f((m_reg - mn) * C); m_reg = mn; }
  float mnC = -mn * C;
  for (int r = 0; r < 16; ++r) p0[r] = fmaf(p0[r], C, mnC); for (int r = 0; r < 16; ++r) p1[r] = fmaf(p1[r], C, mnC);
  for (int r = 0; r < 16; ++r) p0[r] = __builtin_amdgcn_exp2f(p0[r]);
}
DI void finishSM(f32x16& p0, f32x16& p1, float alpha, float& l_reg, bf16x8& pa0, bf16x8& pa1, bf16x8& pa2, bf16x8& pa3) {
  for (int r = 0; r < 16; ++r) p1[r] = __builtin_amdgcn_exp2f(p1[r]);
  float ps = 0; for (int r = 0; r < 16; ++r) ps += p0[r]; for (int r = 0; r < 16; ++r) ps += p1[r];
  { auto rr = __builtin_amdgcn_permlane32_swap(__float_as_uint(ps), __float_as_uint(ps), false, false);
    ps = __uint_as_float(rr[0]) + __uint_as_float(rr[1]); }
  l_reg = l_reg * alpha + ps;
#define PK4(P, BASE, OUT) do { unsigned a0 = cvtpk(P[BASE + 0], P[BASE + 1]), a1 = cvtpk(P[BASE + 2], P[BASE + 3]);   \
    unsigned b0 = cvtpk(P[BASE + 4], P[BASE + 5]), b1 = cvtpk(P[BASE + 6], P[BASE + 7]);                              \
    auto r0 = __builtin_amdgcn_permlane32_swap(a0, b0, false, false); auto r1 = __builtin_amdgcn_permlane32_swap(a1, b1, false, false); \
    u32x4 w = {r0[0], r1[0], r0[1], r1[1]}; OUT = *reinterpret_cast<bf16x8*>(&w); } while (0)
  PK4(p0, 0, pa0); PK4(p0, 8, pa1); PK4(p1, 0, pa2); PK4(p1, 8, pa3);
#undef PK4
}
DI void qkt(f32x16& p0, f32x16& p1, const bf16_t* Ks, const bf16x8* qr, int r32, int hi) {
  p0 = f32x16{}; p1 = f32x16{};
  for (int d0 = 0; d0 < 8; ++d0) { int cb = (d0 * 16 + hi * 8) * 2;
    bf16x8 b0 = *reinterpret_cast<const bf16x8*>((const char*)Ks + KSWZ(r32, cb));
    bf16x8 b1 = *reinterpret_cast<const bf16x8*>((const char*)Ks + KSWZ(32 + r32, cb));
    p0 = __builtin_amdgcn_mfma_f32_32x32x16_bf16(b0, qr[d0], p0, 0, 0, 0);
    p1 = __builtin_amdgcn_mfma_f32_32x32x16_bf16(b1, qr[d0], p1, 0, 0, 0); }
}
DI int v_st(int k, int c) { const int kk = (k & ~0xC) | ((k & 4) << 1) | ((k & 8) >> 1); return ((kk >> 3) * 4 + (c >> 5)) * 512 + ((kk & 7) * 32 + (c & 31)) * 2; }
DI int v_rd_base(int lane) { return ((lane & 3) << 3) | (((lane >> 2) & 3) << 6) | (((lane >> 4) & 1) << 5) | (((lane >> 5) & 1) << 8); }
constexpr int v_rd_off(int d0, int ks, int half) { return d0 * 512 + ks * 4096 + half * 2048; }
template <int OFF> DI s16x4 tr_read(int vb) {
  s16x4 r; asm volatile("ds_read_b64_tr_b16 %0, %1 offset:%2" : "=&v"(r) : "v"(vb), "i"(OFF) : "memory"); return r;
}
template <int D0> DI void pv_one(f32x16& od, int vb, bf16x8 pa0, bf16x8 pa1, bf16x8 pa2, bf16x8 pa3) {
  const s16x4 l0 = tr_read<v_rd_off(D0, 0, 0)>(vb), h0 = tr_read<v_rd_off(D0, 0, 1)>(vb), l1 = tr_read<v_rd_off(D0, 1, 0)>(vb), h1 = tr_read<v_rd_off(D0, 1, 1)>(vb);
  const s16x4 l2 = tr_read<v_rd_off(D0, 2, 0)>(vb), h2 = tr_read<v_rd_off(D0, 2, 1)>(vb), l3 = tr_read<v_rd_off(D0, 3, 0)>(vb), h3 = tr_read<v_rd_off(D0, 3, 1)>(vb);
  asm volatile("s_waitcnt lgkmcnt(0)" ::: "memory"); SBAR();
#define PK(L, H) (bf16x8){L[0], L[1], L[2], L[3], H[0], H[1], H[2], H[3]}
  od = __builtin_amdgcn_mfma_f32_32x32x16_bf16(pa0, PK(l0, h0), od, 0, 0, 0);
  od = __builtin_amdgcn_mfma_f32_32x32x16_bf16(pa1, PK(l1, h1), od, 0, 0, 0);
  od = __builtin_amdgcn_mfma_f32_32x32x16_bf16(pa2, PK(l2, h2), od, 0, 0, 0);
  od = __builtin_amdgcn_mfma_f32_32x32x16_bf16(pa3, PK(l3, h3), od, 0, 0, 0);
#undef PK
}
DI void pv_d0(f32x16* o, int vb, bf16x8 pa0, bf16x8 pa1, bf16x8 pa2, bf16x8 pa3) {
  pv_one<0>(o[0], vb, pa0, pa1, pa2, pa3); pv_one<1>(o[1], vb, pa0, pa1, pa2, pa3); pv_one<2>(o[2], vb, pa0, pa1, pa2, pa3); pv_one<3>(o[3], vb, pa0, pa1, pa2, pa3);
}
DI void attn_dense_body(const bf16_t* __restrict__ Qb, const bf16_t* __restrict__ Kh, const bf16_t* __restrict__ Vh, bf16_t* Ob, int seq, char* lds) {
  int tid = threadIdx.x; asm volatile("" : "+v"(tid));
  const int wid = tid >> 6, lane = tid & 63, r32 = lane & 31, hi = lane >> 5;
  bf16_t* V_lds = (bf16_t*)lds; bf16_t* K_lds = (bf16_t*)(lds + 2 * SHM_V);
  float* ws = (float*)(lds + 2 * SHM_V + 2 * SHM_K) + wid * 64; float* li_l = ws; float* al_l = ws + 32;
  float m_reg = -1e30f, l_reg = 0; f32x16 o[4] = {}; bf16x8 qr[8];
  const bf16_t* Qw = Qb + (long)(wid * QBLK + r32) * LDQ + hi * 8;
#pragma unroll
  for (int d0 = 0; d0 < 8; ++d0) qr[d0] = ld8(Qw + d0 * 16);
  const int sr = tid >> 4, sc = (tid & 15) * 8, vst0 = v_st(sr, sc), vst1 = v_st(32 + sr, sc);
  const int vb0 = (int)(uintptr_t)V_lds + v_rd_base(lane);
  constexpr int SDEPTH = 1;
  struct { bf16x8 vs0, vs1, ks0, ks1; } sr_[SDEPTH];
#define SLOAD(i, k0) do { sr_[i].vs0 = ld8(&Vh[(long)((k0) + sr) * LDK + sc]); sr_[i].vs1 = ld8(&Vh[(long)((k0) + 32 + sr) * LDK + sc]); \
    sr_[i].ks0 = ld8(&Kh[(long)((k0) + sr) * LDK + sc]); sr_[i].ks1 = ld8(&Kh[(long)((k0) + 32 + sr) * LDK + sc]); } while (0)
#define SWRITE(b, i) do { *(bf16x8*)((char*)V_lds + (b) * SHM_V + vst0) = sr_[i].vs0;          \
    *(bf16x8*)((char*)V_lds + (b) * SHM_V + vst1) = sr_[i].vs1; int kc = sc * 2;               \
    *(bf16x8*)((char*)K_lds + (b) * SHM_K + KSWZ(sr, kc)) = sr_[i].ks0;                       \
    *(bf16x8*)((char*)K_lds + (b) * SHM_K + KSWZ(32 + sr, kc)) = sr_[i].ks1; } while (0)
#define SWAIT() do { if constexpr (SDEPTH == 2) asm volatile("s_waitcnt vmcnt(4)" ::: "memory"); else asm volatile("s_waitcnt vmcnt(0)" ::: "memory"); } while (0)
#define RESC(a) do { if (__any((a) < 1.f)) { if (hi == 0) al_l[r32] = (a); asm volatile("s_waitcnt lgkmcnt(0)" ::: "memory"); \
    for (int d = 0; d < 4; ++d) for (int r = 0; r < 16; ++r) o[d][r] *= al_l[crow(r, hi)]; } } while (0)
  f32x16 pA0, pA1, pB0, pB1; float mnA, mnB, alA, alB; bf16x8 pa0, pa1, pa2, pa3; const int NT = seq / KVBLK;
  constexpr int SE = 0, SO = SDEPTH - 1;
  SLOAD(SE, 0); asm volatile("s_waitcnt vmcnt(0)" ::: "memory"); SWRITE(0, SE); __syncthreads();
  qkt(pA0, pA1, K_lds, qr, r32, hi); partialSM(pA0, pA1, m_reg, mnA, alA);
  SLOAD(SO, KVBLK); if constexpr (SDEPTH == 2) { if (2 < NT) SLOAD(SE, 2 * KVBLK); }
  SWAIT(); SWRITE(1, SO); __syncthreads();
  for (int j = 1; j + 1 < NT; j += 2) {
    SBAR(); qkt(pB0, pB1, (bf16_t*)((char*)K_lds + SHM_K), qr, r32, hi);
    finishSM(pA0, pA1, alA, l_reg, pa0, pa1, pa2, pa3); SBAR();
    SLOAD(SO, (j + SDEPTH) * KVBLK); SBAR();
    pv_d0(o, vb0, pa0, pa1, pa2, pa3); partialSM(pB0, pB1, m_reg, mnB, alB);
    __syncthreads(); SWAIT(); SWRITE(0, SE);
    RESC(alB); __syncthreads();
    SBAR(); qkt(pA0, pA1, K_lds, qr, r32, hi);
    finishSM(pB0, pB1, alB, l_reg, pa0, pa1, pa2, pa3); SBAR();
    if (SDEPTH == 1 || j + 3 < NT) SLOAD(SE, (j + 1 + SDEPTH) * KVBLK); SBAR();
    pv_d0(o, vb0 + (int)SHM_V, pa0, pa1, pa2, pa3); partialSM(pA0, pA1, m_reg, mnA, alA);
    __syncthreads(); SWAIT(); SWRITE(1, SO);
    RESC(alA); __syncthreads();
  }
  SBAR(); qkt(pB0, pB1, (bf16_t*)((char*)K_lds + SHM_K), qr, r32, hi);
  finishSM(pA0, pA1, alA, l_reg, pa0, pa1, pa2, pa3); SBAR();
  pv_d0(o, vb0, pa0, pa1, pa2, pa3); partialSM(pB0, pB1, m_reg, mnB, alB);
  __syncthreads(); RESC(alB);
  finishSM(pB0, pB1, alB, l_reg, pa0, pa1, pa2, pa3); SBAR();
  pv_d0(o, vb0 + (int)SHM_V, pa0, pa1, pa2, pa3);
  if (hi == 0) li_l[r32] = l_reg; asm volatile("s_waitcnt lgkmcnt(0)" ::: "memory");
  float rli[16];
#pragma unroll
  for (int r = 0; r < 16; ++r) rli[r] = __builtin_amdgcn_rcpf(li_l[crow(r, hi)]);
  bf16_t* Ow = Ob + (long)(wid * QBLK) * LDO;
#pragma unroll
  for (int r = 0; r < 16; ++r) { int orow = crow(r, hi);
    for (int d0 = 0; d0 < 4; ++d0) Ow[(long)orow * LDO + d0 * 32 + r32] = f2bf(o[d0][r] * rli[r]); }
#undef SLOAD
#undef SWRITE
#undef SWAIT
#undef RESC
}
}

struct Args { const float* in[22]; float* out; unsigned char* ws; int ph_lo, ph_hi; };
enum { I_X = 0, I_C, I_CTX, I_CCTX, I_WMOD, I_BMOD, I_NORM1, I_WIN, I_CONVW, I_CONVB, I_DTB, I_ALOG, I_DSKIP, I_SSMN, I_QN, I_KN, I_WSSM, I_WATT, I_WO, I_NORM2, I_WF1, I_WF2 };

DI void transpose_item(const float* src, int ldw, bf16_t* dst, int ldt, char* scr, int lane) {
    if (src == nullptr) {
#pragma unroll
        for (int i = 0; i < 8; ++i) { const int n = i * 8 + (lane >> 3), k = (lane & 7) * 8; *(u32x4*)(dst + (size_t)n * ldt + k) = (u32x4){0u, 0u, 0u, 0u}; }
        return;
    }
    f32x4 v[16];
#pragma unroll
    for (int i = 0; i < 16; ++i) { const int k = i * 4 + (lane >> 4), n = (lane & 15) * 4; v[i] = *(const f32x4*)(src + (size_t)k * ldw + n); }
#pragma unroll
    for (int i = 0; i < 16; ++i) { const int k = i * 4 + (lane >> 4), n = (lane & 15) * 4;
        *(unsigned*)(scr + (k * 66 + n) * 2) = cvt_pk_bf16(v[i][0], v[i][1]); *(unsigned*)(scr + (k * 66 + n + 2) * 2) = cvt_pk_bf16(v[i][2], v[i][3]); }
    asm volatile("s_waitcnt lgkmcnt(0)" ::: "memory");
#pragma unroll
    for (int i = 0; i < 8; ++i) { const int n = i * 8 + (lane >> 3), k = (lane & 7) * 8;
        unsigned short e[8];
#pragma unroll
        for (int j = 0; j < 8; ++j) e[j] = *(const unsigned short*)(scr + ((k + j) * 66 + n) * 2);
        u32x4 w; w.x = e[0] | ((unsigned)e[1] << 16); w.y = e[2] | ((unsigned)e[3] << 16); w.z = e[4] | ((unsigned)e[5] << 16); w.w = e[6] | ((unsigned)e[7] << 16);
        *(u32x4*)(dst + (size_t)n * ldt + k) = w; }
    asm volatile("s_waitcnt lgkmcnt(0)" ::: "memory");
}
template <class F> DI void transpose_matrix(const float* W, int K, int N, bf16_t* Wt, int nd, F srccol, char* scr, int gw, int ngw, int lane) {
    const int kb = K / 64, items = (nd / 64) * kb;
    for (int it = gw; it < items; it += ngw) { const int db = it / kb, k0 = (it % kb) * 64; const int sc = srccol(db);
        transpose_item(sc < 0 ? nullptr : W + (size_t)k0 * N + sc, N, Wt + (size_t)db * 64 * K + k0, K, scr, lane); }
}

DI int rm_off(int row, int col) { return row * 272 + col * 2; }
DI int tr_off(int row, int col) { return row * 272 + ((((col >> 3) ^ (row >> 3)) & 15) << 4) + ((col & 7) << 1); }
#define MFMA32(a, b, c) __builtin_amdgcn_mfma_f32_32x32x16_bf16((a), (b), (c), 0, 0, 0)

__global__ void __launch_bounds__(NTHR, 2) fwd_megakernel(Args args) {
    extern __shared__ __attribute__((aligned(16))) unsigned char lds_raw[];
    cg::grid_group grid = cg::this_grid();
    char* lds = (char*)lds_raw;
    const int G = gridDim.x, bid = blockIdx.x, ngw = G * NWAVES;
#define PHASE_VARS int tid = threadIdx.x; asm volatile("" : "+v"(tid)); const int lane = tid & 63, wave = tid >> 6, gw = bid * NWAVES + wave; (void)lane; (void)wave; (void)gw; unsigned char* ws = args.ws; asm volatile("" : "+s"(ws));
    unsigned char* ws0 = args.ws;
#define PHASE_PTRS const float* x = args.in[I_X]; const float* b_mod = args.in[I_BMOD]; \
    float* MOD = (float*)(ws + WS_MOD); float* DT = (float*)(ws + WS_DT); float* DEC = (float*)(ws + WS_DEC); \
    bf16_t* P = (bf16_t*)(ws + WS_P); bf16_t* XBC = (bf16_t*)(ws + WS_XBC); bf16_t* ST = (bf16_t*)(ws + WS_ST); \
    (void)x; (void)b_mod; (void)MOD; (void)DT; (void)DEC; (void)P; (void)XBC; (void)ST; (void)ws0;
    const int lo = args.ph_lo, hi = args.ph_hi;
#ifndef PH_MASK
#define PH_MASK 0xFFFF
#endif
#define IN(k) (((PH_MASK >> (k)) & 1) && ((k) == 13 || (lo <= (k) && (k) < hi)))
#define SEAM(k) do { if (IN(k) && IN((k) + 1)) grid.sync(); } while (0)

    if (IN(0)) { PHASE_VARS PHASE_PTRS
        char* scr = lds + wave * 8448;
        transpose_matrix(args.in[I_WIN], DM, 13376, (bf16_t*)(ws + WS_WIN), LDP, [](int db) { const int n = db * 64; return n < 6144 ? n : (n < 13312 ? n + 64 : (n < 13376 ? n - 13312 + 6144 : -1)); }, scr, gw, ngw, lane);
        transpose_matrix(args.in[I_WSSM], DM, DM, (bf16_t*)(ws + WS_WSSM), DM, [](int db) { return db * 64; }, scr, gw, ngw, lane);
        transpose_matrix(args.in[I_WATT], DM, DM, (bf16_t*)(ws + WS_WATT), DM, [](int db) { return db * 64; }, scr, gw, ngw, lane);
        transpose_matrix(args.in[I_WO], DM, DM, (bf16_t*)(ws + WS_WO), DM, [](int db) { return db * 64; }, scr, gw, ngw, lane);
        __syncthreads();
        float* sv = (float*)lds;
        for (int it = bid; it < 256; it += G) {
            const int ng = it & 7, kg = it >> 3;
            __syncthreads();
            if (tid < 192) { const int v = tid >> 6, kk = tid & 63, k = kg * 64 + kk; const float cv = v < 2 ? args.in[I_C][v * DM + k] : args.in[I_CCTX][k]; sv[tid] = siluf_(cv); }
            __syncthreads();
            if (tid < 384) {
                const int col = ng * 1536 + tid * 4; const float* wp = args.in[I_WMOD] + (size_t)(kg * 64) * NMOD + col;
                f32x4 a0 = {0.f, 0.f, 0.f, 0.f}, a1 = a0, a2 = a0;
#pragma unroll 8
                for (int kk = 0; kk < 64; ++kk) { const f32x4 w = *(const f32x4*)(wp + (size_t)kk * NMOD); a0 += w * sv[kk]; a1 += w * sv[64 + kk]; a2 += w * sv[128 + kk]; }
#pragma unroll
                for (int j = 0; j < 4; ++j) { atomicAdd(MOD + col + j, a0[j]); atomicAdd(MOD + NMOD + col + j, a1[j]); atomicAdd(MOD + 2 * NMOD + col + j, a2[j]); }
            }
        }
    }
    SEAM(0);

    if (IN(1)) { PHASE_VARS PHASE_PTRS
        bf16_t* XN = (bf16_t*)(ws + WS_XN); const float* norm1 = args.in[I_NORM1];
        for (int r = gw; r < MP; r += ngw) {
            const int b = r / RPB, t = r % RPB; const int v = t < CTXL ? 2 : b;
            const float* src = t < CTXL ? args.in[I_CTX] + (size_t)(b * CTXL + t) * DM : x + (size_t)(b * SEQ + t - CTXL) * DM;
            f32x4 xv[8]; float ss = 0.f;
#pragma unroll
            for (int j = 0; j < 8; ++j) { xv[j] = *(const f32x4*)(src + j * 256 + lane * 4); ss += xv[j][0] * xv[j][0] + xv[j][1] * xv[j][1] + xv[j][2] * xv[j][2] + xv[j][3] * xv[j][3]; }
            const float rstd = rsqrtf(wave_sum(ss) * (1.f / DM) + EPS);
            const float* mv = MOD + (size_t)v * NMOD;
#pragma unroll
            for (int j = 0; j < 8; ++j) { const int col = j * 256 + lane * 4;
                const f32x4 nw = *(const f32x4*)(norm1 + col), sh = *(const f32x4*)(mv + col) + *(const f32x4*)(b_mod + col), sc = *(const f32x4*)(mv + DM + col) + *(const f32x4*)(b_mod + DM + col);
                const f32x4 o = xv[j] * rstd * nw * (sc + 1.f) + sh;
                u32x2 w; w.x = cvt_pk_bf16(o[0], o[1]); w.y = cvt_pk_bf16(o[2], o[3]);
                *(u32x2*)(XN + (size_t)r * DM + col) = w; }
        }
    }
    SEAM(1);

    if (IN(2)) { PHASE_VARS PHASE_PTRS
        pg8::Gemm g{(const bf16_t*)(ws + WS_XN), (const bf16_t*)(ws + WS_WIN), DM, DM, DM};
        pg8::Sched S; S.init(32, 53, G, bid, 2);
        pg8::EpiInProj E{P, DT, args.in[I_DTB]};
        pg8::gemm_phase<pg8::EpiInProj>((LAS unsigned char*)lds_raw, g, S, E);
    }
    SEAM(2);

    if (IN(3)) { PHASE_VARS PHASE_PTRS
        const float* cw = args.in[I_CONVW]; const float* cb = args.in[I_CONVB];
        const int gt = bid * NTHR + tid, ngt = G * NTHR;
        for (int it = gt; it < (MP / 16) * 512; it += ngt) {
            const int cg8 = it & 511, rb = it >> 9, ch = cg8 * 8, r0 = rb * 16;
            const int b = r0 / RPB, t0 = r0 % RPB; const int seg_lo = t0 < CTXL ? b * RPB : b * RPB + CTXL, seg_hi = t0 < CTXL ? b * RPB + CTXL : (b + 1) * RPB;
            float w[5][8], bias[8];
#pragma unroll
            for (int j = 0; j < 5; ++j) { const f32x4 a = *(const f32x4*)(cw + j * 4096 + ch), c2 = *(const f32x4*)(cw + j * 4096 + ch + 4);
                w[j][0] = a[0]; w[j][1] = a[1]; w[j][2] = a[2]; w[j][3] = a[3]; w[j][4] = c2[0]; w[j][5] = c2[1]; w[j][6] = c2[2]; w[j][7] = c2[3]; }
            { const f32x4 a = *(const f32x4*)(cb + ch), c2 = *(const f32x4*)(cb + ch + 4); bias[0] = a[0]; bias[1] = a[1]; bias[2] = a[2]; bias[3] = a[3]; bias[4] = c2[0]; bias[5] = c2[1]; bias[6] = c2[2]; bias[7] = c2[3]; }
            u32x4 win[5];
            const bf16_t* src = P + C_XBC + ch;
#define LDROW(rr) (((rr) >= seg_lo && (rr) < seg_hi) ? *(const u32x4*)(src + (size_t)(rr) * LDP) : (u32x4){0u, 0u, 0u, 0u})
            win[0] = LDROW(r0 - 2); win[1] = LDROW(r0 - 1); win[2] = LDROW(r0); win[3] = LDROW(r0 + 1);
#pragma unroll
            for (int i = 0; i < 16; ++i) {
                win[4] = LDROW(r0 + i + 2);
                float o[8];
#pragma unroll
                for (int e = 0; e < 8; ++e) o[e] = bias[e];
#pragma unroll
                for (int j = 0; j < 5; ++j) { const u32x4 q = win[j];
                    o[0] += w[j][0] * bflo(q.x); o[1] += w[j][1] * bfhi(q.x); o[2] += w[j][2] * bflo(q.y); o[3] += w[j][3] * bfhi(q.y);
                    o[4] += w[j][4] * bflo(q.z); o[5] += w[j][5] * bfhi(q.z); o[6] += w[j][6] * bflo(q.w); o[7] += w[j][7] * bfhi(q.w); }
                u32x4 ov; ov.x = cvt_pk_bf16(siluf_(o[0]), siluf_(o[1])); ov.y = cvt_pk_bf16(siluf_(o[2]), siluf_(o[3])); ov.z = cvt_pk_bf16(siluf_(o[4]), siluf_(o[5])); ov.w = cvt_pk_bf16(siluf_(o[6]), siluf_(o[7]));
                *(u32x4*)(XBC + (size_t)(r0 + i) * 4096 + ch) = ov;
                win[0] = win[1]; win[1] = win[2]; win[2] = win[3]; win[3] = win[4];
            }
#undef LDROW
        }
        const int sec = lane >> 5, f = lane & 31, e0 = sec * 64 + f, e1 = e0 + 32;
        const float qn0 = args.in[I_QN][e0], qn1 = args.in[I_QN][e1], kn0 = args.in[I_KN][e0], kn1 = args.in[I_KN][e1];
        const float inv_rev = exp2f(-(float)f * (13.287712379549449f / 32.f)) * 0.15915494309189535f;
        for (int r = gw; r < MP; r += ngw) {
            const int t = r % RPB; const bool lat = t >= CTXL; const int tl = t - CTXL;
            float cs = 1.f, sn = 0.f;
            if (lat) { const float pos = (float)(sec == 0 ? (tl >> 6) : (tl & 63)); float rev = pos * inv_rev; rev = rev - floorf(rev); cs = __builtin_amdgcn_cosf(rev); sn = __builtin_amdgcn_sinf(rev); }
            bf16_t* rowp = P + (size_t)r * LDP;
            const int h0 = lat ? 0 : 16;
            for (int hb = h0; hb < 20; hb += 4) {
                float v0[4], v1[4], ss[4];
#pragma unroll
                for (int k = 0; k < 4; ++k) { const int hd = hb + k; bf16_t* hp = rowp + (hd < 16 ? C_Q + hd * 128 : C_K + (hd - 16) * 128);
                    v0[k] = bf2f(hp[e0]); v1[k] = bf2f(hp[e1]); ss[k] = v0[k] * v0[k] + v1[k] * v1[k]; }
#pragma unroll
                for (int k = 0; k < 4; ++k) ss[k] = wave_sum(ss[k]);
#pragma unroll
                for (int k = 0; k < 4; ++k) { const int hd = hb + k; bf16_t* hp = rowp + (hd < 16 ? C_Q + hd * 128 : C_K + (hd - 16) * 128);
                    const float rstd = rsqrtf(ss[k] * (1.f / 128.f) + EPS);
                    const float n0 = v0[k] * rstd * (hd < 16 ? qn0 : kn0), n1 = v1[k] * rstd * (hd < 16 ? qn1 : kn1);
                    hp[e0] = f2bf(n0 * cs - n1 * sn); hp[e1] = f2bf(n1 * cs + n0 * sn); }
            }
        }
    }
    SEAM(3);

    if (IN(4)) { PHASE_VARS PHASE_PTRS
        char* BT = lds;
        char* XT = lds + 34816;
        float* dtv = (float*)(lds + 104448);
        float* wv = dtv + 1024;
        const float* a_log = args.in[I_ALOG];
        for (int it = bid; it < NB * NSLOT * 8; it += G) {
            const int g = it & 7, slot = (it >> 3) % NSLOT, b = it / (8 * NSLOT); const int row0 = b * RPB + slot * 128;
            __syncthreads();
#pragma unroll
            for (int i = 0; i < 4; ++i) { const int idx = tid + i * NTHR, l = idx >> 4, n0 = (idx & 15) * 8;
                const u32x4 q = *(const u32x4*)(XBC + (size_t)(row0 + l) * 4096 + 2048 + g * 128 + n0);
                const unsigned short e[8] = {(unsigned short)q.x, (unsigned short)(q.x >> 16), (unsigned short)q.y, (unsigned short)(q.y >> 16), (unsigned short)q.z, (unsigned short)(q.z >> 16), (unsigned short)q.w, (unsigned short)(q.w >> 16)};
#pragma unroll
                for (int j = 0; j < 8; ++j) *(unsigned short*)(BT + tr_off(n0 + j, l)) = e[j]; }
#pragma unroll
            for (int i = 0; i < 8; ++i) { const int idx = tid + i * NTHR, l = idx >> 5, p0 = (idx & 31) * 8;
                const u32x4 q = *(const u32x4*)(XBC + (size_t)(row0 + l) * 4096 + g * 256 + p0);
                const unsigned short e[8] = {(unsigned short)q.x, (unsigned short)(q.x >> 16), (unsigned short)q.y, (unsigned short)(q.y >> 16), (unsigned short)q.z, (unsigned short)(q.z >> 16), (unsigned short)q.w, (unsigned short)(q.w >> 16)};
#pragma unroll
                for (int j = 0; j < 8; ++j) *(unsigned short*)(XT + tr_off(p0 + j, l)) = e[j]; }
#pragma unroll
            for (int i = 0; i < 2; ++i) { const int idx = tid + i * NTHR, hd = idx >> 7, l = idx & 127, dir = hd >> 2, hh = hd & 3;
                dtv[idx] = DT[(size_t)(row0 + l) * 64 + dir * 32 + g * 4 + hh]; }
            __syncthreads();
#pragma unroll
            for (int i = 0; i < 2; ++i) { const int idx = tid + i * NTHR, hd = idx >> 7, l = idx & 127, dir = hd >> 2, hh = hd & 3;
                const float A = -__expf(a_log[dir * 32 + g * 4 + hh]);
                float s_lt = 0.f, s_gt = 0.f, s_all = 0.f;
                for (int q = 0; q < 128; ++q) { const float a = dtv[hd * 128 + q]; s_all += a; s_lt += q < l ? a : 0.f; s_gt += q > l ? a : 0.f; }
                wv[idx] = __expf((dir == 0 ? s_gt : s_lt) * A) * dtv[idx];
                if (l == 0) DEC[((size_t)(b * 2 + dir) * NSLOT + slot) * 32 + g * 4 + hh] = __expf(s_all * A); }
            __syncthreads();
            const int hh = wave >> 1, dir = wave & 1, hd = dir * 4 + hh, r = lane & 31, h = lane >> 5;
            f32x16 acc[2][4];
#pragma unroll
            for (int a = 0; a < 2; ++a)
#pragma unroll
                for (int c = 0; c < 4; ++c) acc[a][c] = f32x16{};
#pragma unroll 2
            for (int ks = 0; ks < 8; ++ks) {
                const int k0 = ks * 16 + 8 * h;
                const f32x4 w0 = *(const f32x4*)(wv + hd * 128 + k0), w1 = *(const f32x4*)(wv + hd * 128 + k0 + 4);
                bf16x8 xf[2], bfr[4];
#pragma unroll
                for (int tp = 0; tp < 2; ++tp) { const u32x4 q = *(const u32x4*)(XT + tr_off(hh * 64 + tp * 32 + r, k0));
                    u32x4 o; o.x = cvt_pk_bf16(bflo(q.x) * w0[0], bfhi(q.x) * w0[1]); o.y = cvt_pk_bf16(bflo(q.y) * w0[2], bfhi(q.y) * w0[3]);
                    o.z = cvt_pk_bf16(bflo(q.z) * w1[0], bfhi(q.z) * w1[1]); o.w = cvt_pk_bf16(bflo(q.w) * w1[2], bfhi(q.w) * w1[3]);
                    xf[tp] = __builtin_bit_cast(bf16x8, o); }
#pragma unroll
                for (int tn = 0; tn < 4; ++tn) bfr[tn] = *(const bf16x8*)(BT + tr_off(tn * 32 + r, k0));
#pragma unroll
                for (int tp = 0; tp < 2; ++tp)
#pragma unroll
                    for (int tn = 0; tn < 4; ++tn) acc[tp][tn] = MFMA32(bfr[tn], xf[tp], acc[tp][tn]);
            }
            bf16_t* sp = ST + ((size_t)(b * 2 + dir) * NSLOT + slot) * PLANE + (size_t)(g * 4 + hh) * 64 * 128;
#pragma unroll
            for (int tp = 0; tp < 2; ++tp)
#pragma unroll
                for (int tn = 0; tn < 4; ++tn)
#pragma unroll
                    for (int q = 0; q < 4; ++q) { const f32x16& a = acc[tp][tn];
                        u32x2 w; w.x = cvt_pk_bf16(a[4 * q], a[4 * q + 1]); w.y = cvt_pk_bf16(a[4 * q + 2], a[4 * q + 3]);
                        *(u32x2*)(sp + (size_t)(tp * 32 + r) * 128 + tn * 32 + 8 * q + 4 * h) = w; }
        }
    }
    SEAM(4);

    if (IN(5)) { PHASE_VARS PHASE_PTRS
        const int gt = bid * NTHR + tid, ngt = G * NTHR;
        for (int it = gt; it < NB * 2 * 32 * 64 * 16; it += ngt) {
            const int e = (it & 32767) * 8, head = (it >> 10) & 31, bd = it >> 15, dir = bd & 1;
            bf16_t* base = ST + (size_t)bd * NSLOT * PLANE + e; const float* dec = DEC + (size_t)bd * NSLOT * 32 + head;
            float run[8] = {0.f, 0.f, 0.f, 0.f, 0.f, 0.f, 0.f, 0.f};
#pragma unroll
            for (int half = 0; half < 2; ++half) {
                u32x4 v[17]; float dc[17];
#pragma unroll
                for (int s = 0; s < 17; ++s) { const int step = half * 17 + s; const int slot = dir == 0 ? step : (step == 0 ? 1 : (step == 1 ? 0 : 35 - step));
                    v[s] = *(const u32x4*)(base + (size_t)slot * PLANE); dc[s] = dec[slot * 32]; }
#pragma unroll
                for (int s = 0; s < 17; ++s) { const int step = half * 17 + s; const int slot = dir == 0 ? step : (step == 0 ? 1 : (step == 1 ? 0 : 35 - step));
                    u32x4 o; o.x = cvt_pk_bf16(run[0], run[1]); o.y = cvt_pk_bf16(run[2], run[3]); o.z = cvt_pk_bf16(run[4], run[5]); o.w = cvt_pk_bf16(run[6], run[7]);
                    *(u32x4*)(base + (size_t)slot * PLANE) = o;
                    const float d = dc[s];
                    run[0] = d * run[0] + bflo(v[s].x); run[1] = d * run[1] + bfhi(v[s].x); run[2] = d * run[2] + bflo(v[s].y); run[3] = d * run[3] + bfhi(v[s].y);
                    run[4] = d * run[4] + bflo(v[s].z); run[5] = d * run[5] + bfhi(v[s].z); run[6] = d * run[6] + bflo(v[s].w); run[7] = d * run[7] + bfhi(v[s].w); }
            }
        }
    }
    SEAM(5);

    if (IN(6)) { PHASE_VARS PHASE_PTRS
        char* Cs = lds;
        char* Bs = lds + 34816;
        char* XT = lds + 69632;
        char* Hf = lds + 87040;
        char* Hb = lds + 104448;
        float* fa = (float*)(lds + 121856);
        const float* a_log = args.in[I_ALOG]; const float* d_skip = args.in[I_DSKIP];
        for (int it = bid; it < NB * 32 * 32; it += G) {
            const int head = it & 31, c = (it >> 5) & 31, b = it >> 10, g = head >> 2, slot = c + 2; const int row0 = b * RPB + slot * 128;
            __syncthreads();
#pragma unroll
            for (int i = 0; i < 4; ++i) { const int idx = tid + i * NTHR, l = idx >> 4, n0 = (idx & 15) * 8; const bf16_t* rp = XBC + (size_t)(row0 + l) * 4096 + 2048 + g * 128 + n0;
                *(u32x4*)(Bs + rm_off(l, n0)) = *(const u32x4*)rp; *(u32x4*)(Cs + rm_off(l, n0)) = *(const u32x4*)(rp + 1024); }
#pragma unroll
            for (int i = 0; i < 2; ++i) { const int idx = tid + i * NTHR, l = idx >> 3, p0 = (idx & 7) * 8;
                const u32x4 q = *(const u32x4*)(XBC + (size_t)(row0 + l) * 4096 + head * 64 + p0);
                const unsigned short e[8] = {(unsigned short)q.x, (unsigned short)(q.x >> 16), (unsigned short)q.y, (unsigned short)(q.y >> 16), (unsigned short)q.z, (unsigned short)(q.z >> 16), (unsigned short)q.w, (unsigned short)(q.w >> 16)};
#pragma unroll
                for (int j = 0; j < 8; ++j) *(unsigned short*)(XT + tr_off(p0 + j, l)) = e[j]; }
#pragma unroll
            for (int i = 0; i < 2; ++i) { const int idx = tid + i * NTHR, p = idx >> 4, n0 = (idx & 15) * 8;
                const size_t so = (size_t)slot * PLANE + (size_t)(head * 64 + p) * 128 + n0;
                *(u32x4*)(Hf + rm_off(p, n0)) = *(const u32x4*)(ST + (size_t)(b * 2 + 0) * NSLOT * PLANE + so);
                *(u32x4*)(Hb + rm_off(p, n0)) = *(const u32x4*)(ST + (size_t)(b * 2 + 1) * NSLOT * PLANE + so); }
            if (tid < 256) { const int dir = tid >> 7, l = tid & 127; fa[256 + tid] = DT[(size_t)(row0 + l) * 64 + dir * 32 + head]; }
            __syncthreads();
            if (tid < 256) { const int dir = tid >> 7, l = tid & 127; const float A = -__expf(a_log[dir * 32 + head]);
                float s = 0.f;
                for (int q = 0; q < 128; ++q) { const float a = fa[256 + dir * 128 + q]; s += (dir == 0 ? (q <= l) : (q >= l)) ? a : 0.f; }
                fa[tid] = s * A; }
            __syncthreads();
            const int r = lane & 31, h = lane >> 5, tl = wave >> 1;
            {
                f32x16 ga[2] = {f32x16{}, f32x16{}};
#pragma unroll 2
                for (int ks = 0; ks < 8; ++ks) { const int k0 = ks * 16 + 8 * h;
                    const bf16x8 cf = *(const bf16x8*)(Cs + rm_off(tl * 32 + r, k0));
#pragma unroll
                    for (int t2 = 0; t2 < 2; ++t2) { const bf16x8 bf_ = *(const bf16x8*)(Bs + rm_off(((wave & 1) * 2 + t2) * 32 + r, k0)); ga[t2] = MFMA32(bf_, cf, ga[t2]); } }
                const int l = tl * 32 + r; const float cfl = fa[l], rcl = fa[128 + l], dsk = d_skip[head];
                __syncthreads();
#pragma unroll
                for (int t2 = 0; t2 < 2; ++t2) { const int ts = (wave & 1) * 2 + t2;
#pragma unroll
                    for (int q = 0; q < 4; ++q) { const int s0 = ts * 32 + 8 * q + 4 * h;
                        const f32x4 cfs = *(const f32x4*)(fa + s0), rcs = *(const f32x4*)(fa + 128 + s0), dfs = *(const f32x4*)(fa + 256 + s0), dbs = *(const f32x4*)(fa + 384 + s0);
                        float m[4];
#pragma unroll
                        for (int j = 0; j < 4; ++j) { const int s = s0 + j;
                            const float wf = s <= l ? __expf(fminf(cfl - cfs[j], 0.f)) * dfs[j] : 0.f;
                            const float wb = s >= l ? __expf(fminf(rcl - rcs[j], 0.f)) * dbs[j] : 0.f;
                            m[j] = ga[t2][4 * q + j] * (wf + wb) + (s == l ? dsk : 0.f); }
                        u32x2 w; w.x = cvt_pk_bf16(m[0], m[1]); w.y = cvt_pk_bf16(m[2], m[3]);
                        *(u32x2*)(Bs + rm_off(l, s0)) = w; } }
            }
            __syncthreads();
            {
                const int tp = wave & 1;
                f32x16 aD = f32x16{}, aF = f32x16{}, aB = f32x16{};
#pragma unroll 2
                for (int ks = 0; ks < 8; ++ks) { const int k0 = ks * 16 + 8 * h;
                    const bf16x8 mf = *(const bf16x8*)(Bs + rm_off(tl * 32 + r, k0)), xf = *(const bf16x8*)(XT + tr_off(tp * 32 + r, k0));
                    const bf16x8 cf = *(const bf16x8*)(Cs + rm_off(tl * 32 + r, k0)), hf = *(const bf16x8*)(Hf + rm_off(tp * 32 + r, k0)), hb = *(const bf16x8*)(Hb + rm_off(tp * 32 + r, k0));
                    aD = MFMA32(mf, xf, aD); aF = MFMA32(cf, hf, aF); aB = MFMA32(cf, hb, aB); }
                bf16_t* yp = P + (size_t)row0 * LDP + C_XBC + head * 64 + tp * 32 + r;
#pragma unroll
                for (int i = 0; i < 16; ++i) { const int l = tl * 32 + att::crow(i, h);
                    const float y = aD[i] + __expf(fa[l]) * aF[i] + __expf(fa[128 + l]) * aB[i];
                    yp[(size_t)l * LDP] = f2bf(y); }
            }
        }
    }
    if (IN(6) && IN(13)) { PHASE_VARS PHASE_PTRS
        for (int u = bid; u < 512; u += G) {
            const int b = u >> 8, w = u & 255, xcd = w & 7, j = w >> 3, kvh = xcd >> 1, idx = (xcd & 1) * 32 + j, rep = idx >> 4, qb = idx & 15, head = kvh * 4 + rep;
            bf16_t* Qb = P + (size_t)(b * RPB + CTXL + qb * 256) * LDP + C_Q + head * 128;
            const bf16_t* Kh = P + (size_t)(b * RPB) * LDP + C_K + kvh * 128; const bf16_t* Vh = P + (size_t)(b * RPB) * LDP + C_V + kvh * 128;
            att::attn_dense_body(Qb, Kh, Vh, Qb, RPB, lds);
            __syncthreads();
        }
    }
    SEAM(6);

    if (IN(7)) { PHASE_VARS PHASE_PTRS
        const float* ssmn = args.in[I_SSMN];
        for (int lr = gw; lr < ML; lr += ngw) {
            const int b = lr >> 12, t = lr & 4095; bf16_t* rowp = P + (size_t)(b * RPB + CTXL + t) * LDP;
            u32x2 yv[8], zv[8];
#pragma unroll
            for (int g = 0; g < 8; ++g) { yv[g] = *(const u32x2*)(rowp + C_XBC + g * 256 + lane * 4); zv[g] = *(const u32x2*)(rowp + C_Z + g * 256 + lane * 4); }
#pragma unroll
            for (int g = 0; g < 8; ++g) {
                float v[4] = {bflo(yv[g].x) * siluf_(bflo(zv[g].x)), bfhi(yv[g].x) * siluf_(bfhi(zv[g].x)), bflo(yv[g].y) * siluf_(bflo(zv[g].y)), bfhi(yv[g].y) * siluf_(bfhi(zv[g].y))};
                const float ss = wave_sum(v[0] * v[0] + v[1] * v[1] + v[2] * v[2] + v[3] * v[3]);
                const float rstd = rsqrtf(ss * (1.f / 256.f) + EPS);
                const f32x4 nw = *(const f32x4*)(ssmn + g * 256 + lane * 4);
                u32x2 w; w.x = cvt_pk_bf16(v[0] * rstd * nw[0], v[1] * rstd * nw[1]); w.y = cvt_pk_bf16(v[2] * rstd * nw[2], v[3] * rstd * nw[3]);
                *(u32x2*)(rowp + C_Z + g * 256 + lane * 4) = w; }
        }
        __syncthreads();
        char* scr = lds + wave * 8448;
        transpose_matrix(args.in[I_WF1], DM, 2 * DFF, (bf16_t*)(ws + WS_WF1), 2 * DFF, [](int db) { const int pn = db >> 2, q = db & 3; return q < 2 ? pn * 128 + q * 64 : DFF + pn * 128 + (q - 2) * 64; }, scr, gw, ngw, lane);
        transpose_matrix(args.in[I_WF2], DFF, DM, (bf16_t*)(ws + WS_WF2), DM, [](int db) { return db * 64; }, scr, gw, ngw, lane);
        __syncthreads();
    }
    SEAM(7);

    if (IN(8)) { PHASE_VARS PHASE_PTRS
        pg8::Sched S; S.init(32, 8, G, bid, 1);
        { pg8::Gemm g{P + C_Z, (const bf16_t*)(ws + WS_WSSM), LDP, DM, DM}; pg8::EpiBranch<0> E{P}; pg8::gemm_phase<pg8::EpiBranch<0>>((LAS unsigned char*)lds_raw, g, S, E); }
        __syncthreads();
        { pg8::Gemm g{P + C_Q, (const bf16_t*)(ws + WS_WATT), LDP, DM, DM}; pg8::EpiBranch<1> E{P}; pg8::gemm_phase<pg8::EpiBranch<1>>((LAS unsigned char*)lds_raw, g, S, E); }
    }
    SEAM(8);

    if (IN(9)) { PHASE_VARS PHASE_PTRS
        pg8::Sched S; S.init(32, 8, G, bid, 1);
        pg8::Gemm g{P + C_G, (const bf16_t*)(ws + WS_WO), LDP, DM, DM};
        pg8::EpiResid<0> E{x, args.out, MOD, b_mod, 2 * DM};
        pg8::gemm_phase<pg8::EpiResid<0>>((LAS unsigned char*)lds_raw, g, S, E);
    }
    SEAM(9);

    if (IN(10)) { PHASE_VARS PHASE_PTRS
        bf16_t* XN2 = (bf16_t*)(ws + WS_XN2); const float* norm2 = args.in[I_NORM2];
        for (int r = gw; r < ML; r += ngw) {
            const int b = r >> 12; const float* src = args.out + (size_t)r * DM;
            f32x4 xv[8]; float ss = 0.f;
#pragma unroll
            for (int j = 0; j < 8; ++j) { xv[j] = *(const f32x4*)(src + j * 256 + lane * 4); ss += xv[j][0] * xv[j][0] + xv[j][1] * xv[j][1] + xv[j][2] * xv[j][2] + xv[j][3] * xv[j][3]; }
            const float rstd = rsqrtf(wave_sum(ss) * (1.f / DM) + EPS);
            const float* mv = MOD + (size_t)b * NMOD;
#pragma unroll
            for (int j = 0; j < 8; ++j) { const int col = j * 256 + lane * 4;
                const f32x4 nw = *(const f32x4*)(norm2 + col), sh = *(const f32x4*)(mv + 3 * DM + col) + *(const f32x4*)(b_mod + 3 * DM + col), sc = *(const f32x4*)(mv + 4 * DM + col) + *(const f32x4*)(b_mod + 4 * DM + col);
                const f32x4 o = xv[j] * rstd * nw * (sc + 1.f) + sh;
                u32x2 w; w.x = cvt_pk_bf16(o[0], o[1]); w.y = cvt_pk_bf16(o[2], o[3]);
                *(u32x2*)(XN2 + (size_t)r * DM + col) = w; }
        }
    }
    SEAM(10);

    if (IN(11)) { PHASE_VARS PHASE_PTRS
        pg8::Sched S; S.init(32, 44, G, bid, 0);
        pg8::Gemm g{(const bf16_t*)(ws + WS_XN2), (const bf16_t*)(ws + WS_WF1), DM, DM, DM};
        pg8::EpiSwiglu E{(bf16_t*)(ws + WS_HID)};
        pg8::gemm_phase<pg8::EpiSwiglu>((LAS unsigned char*)lds_raw, g, S, E);
    }
    SEAM(11);

    if (IN(12)) { PHASE_VARS PHASE_PTRS
        pg8::Sched S; S.init(32, 8, G, bid, 0);
        pg8::Gemm g{(const bf16_t*)(ws + WS_HID), (const bf16_t*)(ws + WS_WF2), DFF, DFF, DFF};
        pg8::EpiResid<1> E{args.out, args.out, MOD, b_mod, 5 * DM};
        pg8::gemm_phase<pg8::EpiResid<1>>((LAS unsigned char*)lds_raw, g, S, E);
    }
#undef IN
#undef SEAM
}

constexpr int N_PHASES = 13;
#ifndef MK_PER_PHASE
#define MK_PER_PHASE 0
#endif
extern "C" void kernel_launch(void* const* d_in, const int* in_sizes, int n_in, void* d_out, int out_size, void* d_ws, size_t ws_size, hipStream_t stream) {
    static int grid = 0;
    if (grid == 0) {
        if (n_in != 22 || out_size != ML * DM || ws_size < WS_END) { fprintf(stderr, "kernel_launch: bad shapes n_in %d out %d ws %zu (need %zu)\n", n_in, out_size, ws_size, (size_t)WS_END); grid = -1; return; }
        int dev = 0, cus = 0, per_cu = 0;
        if (hipGetDevice(&dev) != hipSuccess || hipDeviceGetAttribute(&cus, hipDeviceAttributeMultiprocessorCount, dev) != hipSuccess) { grid = -1; return; }
        if (hipFuncSetAttribute((const void*)fwd_megakernel, hipFuncAttributeMaxDynamicSharedMemorySize, LDS_BYTES) != hipSuccess) { fprintf(stderr, "kernel_launch: hipFuncSetAttribute failed\n"); grid = -1; return; }
        if (hipOccupancyMaxActiveBlocksPerMultiprocessor(&per_cu, (const void*)fwd_megakernel, NTHR, LDS_BYTES) != hipSuccess || per_cu < 1) { fprintf(stderr, "kernel_launch: occupancy query says %d\n", per_cu); (void)hipGetLastError(); per_cu = 1; }
        grid = cus;
    }
    if (grid < 0) return;
    (void)hipMemsetAsync((char*)d_ws, 0, ZERO_BYTES, stream);
    Args a{};
    for (int i = 0; i < 22; ++i) a.in[i] = (const float*)d_in[i];
    a.out = (float*)d_out; a.ws = (unsigned char*)d_ws;
#if MK_PER_PHASE
    for (int p = 0; p < N_PHASES; ++p) { a.ph_lo = p; a.ph_hi = p + 1; hipLaunchKernelGGL(fwd_megakernel, dim3(grid), dim3(NTHR), LDS_BYTES, stream, a); }
#else
    a.ph_lo = 0; a.ph_hi = N_PHASES;
    void* kargs[] = {&a};
    hipError_t e = hipLaunchCooperativeKernel((const void*)fwd_megakernel, dim3(grid), dim3(NTHR), kargs, LDS_BYTES, stream);
    if (e != hipSuccess) fprintf(stderr, "kernel_launch: cooperative launch failed: %s (grid %d)\n", hipGetErrorString(e), grid);
#endif
}
```

```cpp
#include <hip/hip_runtime.h>
#include <hip/hip_cooperative_groups.h>
#include <cstdio>
#include <cstdint>
namespace cg = cooperative_groups;

#define DI __device__ __forceinline__
#define LAS __attribute__((address_space(3)))
typedef unsigned short bf16_t;
typedef short bf16x8 __attribute__((ext_vector_type(8)));
typedef short s16x4 __attribute__((ext_vector_type(4)));
typedef float f32x2 __attribute__((ext_vector_type(2)));
typedef float f32x4 __attribute__((ext_vector_type(4)));
typedef float f32x16 __attribute__((ext_vector_type(16)));
typedef unsigned u32x2 __attribute__((ext_vector_type(2)));
typedef unsigned u32x4 __attribute__((ext_vector_type(4)));

constexpr int DM = 2048, NB = 2, SEQ = 4096, CTXL = 256, RPB = SEQ + CTXL  , MP = NB * RPB  , ML = NB * SEQ;
constexpr int LDP = 13568;
constexpr int C_Z = 0, C_XBC = 2048, C_Q = 6144, C_K = 8192, C_V = 8704, C_G = 9216, C_DT = 13312;
constexpr int DFF = 5632, NMOD = 12288, NSLOT = 34;
constexpr float EPS = 1e-6f;
constexpr int NTHR = 512, NWAVES = 8;
constexpr int LDS_BYTES = 144 * 1024;

constexpr size_t al256(size_t x) { return (x + 255) / 256 * 256; }
constexpr size_t WS_CTL = 0;
constexpr size_t WS_MOD = 16384;
constexpr size_t ZERO_BYTES = WS_MOD + (size_t)3 * NMOD * 4;
constexpr size_t WS_DT  = al256(ZERO_BYTES);
constexpr size_t WS_DEC = al256(WS_DT + (size_t)MP * 64 * 4);
constexpr size_t WS_R1  = al256(WS_DEC + (size_t)NB * 2 * NSLOT * 32 * 4);
constexpr size_t SZ_WIN = (size_t)LDP * DM * 2;
constexpr size_t WS_WIN = WS_R1;
constexpr size_t WS_XN  = WS_R1 + SZ_WIN;
constexpr size_t SZ_R1  = SZ_WIN + (size_t)MP * DM * 2;
constexpr size_t WS_XBC = WS_R1;
constexpr size_t WS_XN2 = WS_R1;
constexpr size_t WS_R2  = al256(WS_R1 + SZ_R1);
constexpr size_t WS_WSSM = WS_R2, WS_WATT = WS_R2 + (size_t)DM * DM * 2, WS_WO = WS_R2 + (size_t)2 * DM * DM * 2;
constexpr size_t WS_R3  = al256(WS_R2 + (size_t)3 * DM * DM * 2);
constexpr size_t WS_P   = WS_R3;
constexpr size_t WS_HID = WS_R3;
constexpr size_t WS_R4  = al256(WS_R3 + (size_t)MP * LDP * 2);
constexpr size_t PLANE  = (size_t)32 * 64 * 128;
constexpr size_t WS_ST  = WS_R4;
constexpr size_t WS_WF1 = WS_R4;
constexpr size_t WS_WF2 = WS_R4 + (size_t)2 * DFF * DM * 2;
constexpr size_t WS_END = al256(WS_R4 + (size_t)NB * 2 * NSLOT * PLANE * 2);
static_assert((size_t)2 * DFF * DM * 2 + (size_t)DM * DFF * 2 <= (size_t)NB * 2 * NSLOT * PLANE * 2, "ffn weights fit the state region");
static_assert((size_t)MP * 4096 * 2 <= SZ_R1, "xbc fits r1");

DI unsigned cvt_pk_bf16(float lo, float hi) { unsigned r; asm volatile("v_cvt_pk_bf16_f32 %0, %1, %2" : "=v"(r) : "v"(lo), "v"(hi)); return r; }
DI float bflo(unsigned w) { return __uint_as_float(w << 16); }
DI float bfhi(unsigned w) { return __uint_as_float(w & 0xffff0000u); }
DI float bf2f(bf16_t b) { return __uint_as_float(((unsigned)b) << 16); }
DI bf16_t f2bf(float x) { return (bf16_t)(cvt_pk_bf16(x, 0.f) & 0xffffu); }
DI float wave_sum(float v) { for (int o = 32; o >= 1; o >>= 1) v += __shfl_xor(v, o); return v; }
DI void wave_scan128(const float* a, int lane, float& le0, float& le1, float& tot, float& a0, float& a1) {
    const f32x2 v = *(const f32x2*)(a + 2 * lane); a0 = v.x; a1 = v.y; float inc = a0 + a1;
#pragma unroll
    for (int o = 1; o < 64; o <<= 1) { const float t = __shfl_up(inc, o); inc += lane >= o ? t : 0.f; }
    le0 = inc - a1; le1 = inc; tot = __shfl(inc, 63);
}
DI float sigmoidf_(float x) { return __builtin_amdgcn_rcpf(1.f + __builtin_amdgcn_exp2f(-1.4426950408889634f * x)); }
DI float siluf_(float x) { return x * __builtin_amdgcn_rcpf(1.f + __builtin_amdgcn_exp2f(-1.4426950408889634f * x)); }
DI float softplusf_(float x) { return fmaxf(x, 0.f) + log1pf(__expf(-fabsf(x))); }

namespace pg8 {
constexpr int BM = 256, BK = 64, HALF = 128, HTB = HALF * BK * 2, STAGE_BYTES = 8 * HTB, NXCD = 8, WGM = 8;
DI int lds_byte(int r, int c) { const int st = (r >> 4) * 2 + (c >> 5), rr = r & 15, cc = c & 31, ob = rr * 64 + cc * 2; return st * 1024 + (ob ^ (((ob >> 9) & 1) << 5)); }
DI void stage_rc(int b, int& R, int& C) { const int st = b / 1024, sb = b % 1024, swz = sb ^ (((sb >> 9) & 1) << 5); R = (st >> 1) * 16 + swz / 64; C = (st & 1) * 32 + (swz % 64) / 2; }
DI int perm32(int rho) { const int n = rho >> 4, i = rho & 15; return 8 * (i >> 2) + 4 * n + (i & 3); }
struct Unit { int pm, pn; };
struct Gemm { const bf16_t* A; const bf16_t* Bt; int lda, ldb, K; size_t a_alt; };
struct Sched {
    int nM, nN, nwg, G, c, mode, total;
    DI void init(int nM_, int nN_, int G_, int c_, int mode_) { nM = nM_; nN = nN_; nwg = nM * nN; G = G_; c = c_; mode = mode_; total = nwg + (mode == 2 ? 42 : 0); }
    DI bool next(int i, Unit& u) const {
        int which = 0; if (mode == 3) { which = i & 1; i >>= 1; }
        const int L = i * G + c; if (L >= total) return false;
        if (L >= nwg) { const int j = L - nwg, t = j / 21, q = j % 21; u.pm = t * 17; u.pn = q < 16 ? 8 + q : (q < 20 ? 32 + (q - 16) : 52); return true; }
        int wgid = L; { const int q = nwg / NXCD, r = nwg % NXCD, xcd = wgid % NXCD, off = wgid / NXCD; wgid = (xcd < r ? xcd * (q + 1) : r * (q + 1) + (xcd - r) * q) + off; }
        const int nig = WGM * nN, gid = wgid / nig, fm = gid * WGM, gsz = (nM - fm) < WGM ? (nM - fm) : WGM;
        int pm = fm + ((wgid % nig) % gsz); const int pn = (wgid % nig) / gsz;
        if (mode) pm = pm + 1 + (pm >= 16 ? 1 : 0);
        u.pm = pm; u.pn = pn + 8 * which; return true;
    }
};

template <class Epi>
DI void gemm_phase(LAS unsigned char* lds, const Gemm g, const Sched& S, const Epi& E, int tid) {
    asm volatile("" : "+v"(tid));
    const int wid = __builtin_amdgcn_readfirstlane(tid >> 6), lane = tid & 63, wr = wid >> 2, wc = wid & 3, fr = lane & 15, fq = lane >> 4;
    const int K = g.K, nt = K / BK;
    unsigned voffA[2], voffB[2];
#pragma unroll
    for (int i = 0; i < 2; ++i) { int R, C; stage_rc(tid * 16 + i * 8192, R, C); const int Rb = Epi::PERM ? ((R & ~31) + perm32(R & 31)) : R;
        voffA[i] = (unsigned)(R * g.lda + C) * 2u; voffB[i] = (unsigned)(Rb * g.ldb + C) * 2u; }
    const size_t kstep = (size_t)(BK * 2);
    const size_t hstepA = (size_t)HALF * g.lda * 2, hstepB = (size_t)HALF * g.ldb * 2;
    const size_t tstepA = 2 * hstepA, tstepB = 2 * hstepB;
    const unsigned ldsw = (unsigned)wid * 1024u;
    const int aoff = lds_byte(wr * 64 + fr, fq * 8), boff = lds_byte(wc * 32 + fr, fq * 8);
#define PG8_SA(b, h) (((b) * 2 + (h)) * HTB)
#define PG8_SB(b, h) ((4 + (b) * 2 + (h)) * HTB)
#define PG8_STAGE(bufoff, gbase, voff) do { _Pragma("unroll") for (int _i = 0; _i < 2; ++_i) \
        __builtin_amdgcn_global_load_lds((const unsigned*)((const char*)(gbase) + (voff)[_i]), (LAS unsigned*)(lds + (bufoff) + ldsw + _i * 8192), 16, 0, 0); } while (0)
#define PG8_LDA(dst, b, h) do { _Pragma("unroll") for (int m = 0; m < 4; ++m) _Pragma("unroll") for (int k = 0; k < 2; ++k) dst[m][k] = *(const LAS bf16x8*)(lds + PG8_SA(b, h) + aoff + m * 2048 + k * 1024); } while (0)
#define PG8_LDB(dst, b, h) do { _Pragma("unroll") for (int n = 0; n < 2; ++n) _Pragma("unroll") for (int k = 0; k < 2; ++k) dst[n][k] = *(const LAS bf16x8*)(lds + PG8_SB(b, h) + boff + n * 2048 + k * 1024); } while (0)
#define PG8_MMA(ai, bj, At, Bt) do { __builtin_amdgcn_s_setprio(1); _Pragma("unroll") for (int m = 0; m < 4; ++m) _Pragma("unroll") for (int n = 0; n < 2; ++n) _Pragma("unroll") for (int k = 0; k < 2; ++k) \
        acc[ai][bj][m][n] = __builtin_amdgcn_mfma_f32_16x16x32_bf16(Bt[n][k], At[m][k], acc[ai][bj][m][n], 0, 0, 0); __builtin_amdgcn_s_setprio(0); } while (0)
#define PG8_WAIT_V(n) asm volatile("s_waitcnt vmcnt(" #n ")" ::: "memory")
#define PG8_WAIT_L(n) asm volatile("s_waitcnt lgkmcnt(" #n ")" ::: "memory")
#define PG8_BAR __builtin_amdgcn_s_barrier()
#define PG8_SCHED __builtin_amdgcn_sched_barrier(0)
    Unit cur, nxt; int ui = 0;
    if (!S.next(0, cur)) return;
    f32x4 acc[2][2][4][2];
#pragma unroll
    for (int a = 0; a < 2; ++a)
#pragma unroll
        for (int b = 0; b < 2; ++b)
#pragma unroll
            for (int m = 0; m < 4; ++m)
#pragma unroll
                for (int n = 0; n < 2; ++n) acc[a][b][m][n] = (f32x4){0.f, 0.f, 0.f, 0.f};
    bf16x8 At[4][2], B0[2][2], B1[2][2];
    const char* cA = (const char*)g.A + (size_t)cur.pm * tstepA + (cur.pn >= 8 ? g.a_alt : (size_t)0); const char* cB = (const char*)g.Bt + (size_t)cur.pn * tstepB;
    PG8_STAGE(PG8_SB(0, 0), cB, voffB); PG8_STAGE(PG8_SA(0, 0), cA, voffA); PG8_STAGE(PG8_SB(0, 1), cB + hstepB, voffB); PG8_STAGE(PG8_SA(0, 1), cA + hstepA, voffA);
    if (wr == 1) PG8_BAR;
    PG8_WAIT_V(4); PG8_BAR;
    PG8_STAGE(PG8_SB(1, 0), cB + kstep, voffB); PG8_STAGE(PG8_SA(1, 0), cA + kstep, voffA); PG8_STAGE(PG8_SB(1, 1), cB + hstepB + kstep, voffB);
    PG8_WAIT_V(6); PG8_BAR;
    for (;;) {
        const bool has_next = S.next(ui + 1, nxt);
        const char* nA = has_next ? (const char*)g.A + (size_t)nxt.pm * tstepA + (nxt.pn >= 8 ? g.a_alt : (size_t)0) : cA; const char* nB = has_next ? (const char*)g.Bt + (size_t)nxt.pn * tstepB : cB;
        for (int t = 0; t < nt; t += 2) {
            const bool last = (t == nt - 2);
            const char* a1 = cA + (size_t)(t + 1) * kstep;
            const char* a2 = last ? nA : cA + (size_t)(t + 2) * kstep; const char* b2 = last ? nB : cB + (size_t)(t + 2) * kstep;
            const char* a3 = a2 + kstep; const char* b3 = b2 + kstep;
            PG8_LDB(B0, 0, 0); PG8_SCHED; PG8_LDA(At, 0, 0); PG8_STAGE(PG8_SA(1, 1), a1 + hstepA, voffA);
            PG8_WAIT_L(8); PG8_BAR; PG8_WAIT_L(0); PG8_MMA(0, 0, At, B0); PG8_BAR; PG8_SCHED;
            PG8_LDB(B1, 0, 1); PG8_STAGE(PG8_SB(0, 0), b2, voffB);
            PG8_BAR; PG8_WAIT_L(0); PG8_MMA(0, 1, At, B1); PG8_BAR;
            PG8_LDA(At, 0, 1); PG8_STAGE(PG8_SA(0, 0), a2, voffA);
            PG8_BAR; PG8_WAIT_L(0); PG8_MMA(1, 0, At, B0); PG8_BAR; PG8_SCHED;
            PG8_STAGE(PG8_SB(0, 1), b2 + hstepB, voffB);
            PG8_WAIT_V(6); PG8_BAR; PG8_MMA(1, 1, At, B1); PG8_BAR;
            PG8_LDB(B0, 1, 0); PG8_SCHED; PG8_LDA(At, 1, 0); PG8_STAGE(PG8_SA(0, 1), a2 + hstepA, voffA);
            PG8_WAIT_L(8); PG8_BAR; PG8_WAIT_L(0); PG8_MMA(0, 0, At, B0); PG8_BAR; PG8_SCHED;
            PG8_LDB(B1, 1, 1); PG8_STAGE(PG8_SB(1, 0), b3, voffB);
            PG8_BAR; PG8_WAIT_L(0); PG8_MMA(0, 1, At, B1); PG8_BAR;
            PG8_LDA(At, 1, 1); PG8_STAGE(PG8_SA(1, 0), a3, voffA);
            PG8_BAR; PG8_WAIT_L(0); PG8_MMA(1, 0, At, B0); PG8_BAR; PG8_SCHED;
            PG8_STAGE(PG8_SB(1, 1), b3 + hstepB, voffB);
            PG8_WAIT_V(6); PG8_BAR; PG8_MMA(1, 1, At, B1); PG8_BAR;
        }
        bool keep_acc = false;
        if constexpr (Epi::CHAIN) { if (cur.pn < 8) { E.mid(acc, cur, wr, wc, fr, fq); keep_acc = true; } else E(acc, cur, wr, wc, fr, fq); }
        else E(acc, cur, wr, wc, fr, fq);
        if (!has_next) break;
        if (!keep_acc)
#pragma unroll
        for (int a = 0; a < 2; ++a)
#pragma unroll
            for (int b = 0; b < 2; ++b)
#pragma unroll
                for (int m = 0; m < 4; ++m)
#pragma unroll
                    for (int n = 0; n < 2; ++n) acc[a][b][m][n] = (f32x4){0.f, 0.f, 0.f, 0.f};
        cur = nxt; cA = nA; cB = nB; ++ui;
    }
    PG8_WAIT_V(0);
    if (wr == 0) PG8_BAR;
    PG8_BAR;
#undef PG8_SA
#undef PG8_SB
#undef PG8_STAGE
#undef PG8_LDA
#undef PG8_LDB
#undef PG8_MMA
#undef PG8_WAIT_V
#undef PG8_WAIT_L
#undef PG8_BAR
#undef PG8_SCHED
}

struct EpiInProj {
    static constexpr bool PERM = true, CHAIN = false;
    bf16_t* P; float* DT; const float* dt_bias;
    DI void operator()(const f32x4 (&acc)[2][2][4][2], const Unit& u, int wr, int wc, int fr, int fq) const {
        const int row0 = u.pm * BM + wr * 64 + fr;
        if (u.pn < 52) {
            const int col0 = u.pn * BM + wc * 32 + 8 * fq;
#pragma unroll
            for (int ai = 0; ai < 2; ++ai)
#pragma unroll
                for (int m = 0; m < 4; ++m) { bf16_t* rowp = P + (size_t)(row0 + ai * HALF + m * 16) * LDP + col0;
#pragma unroll
                    for (int bj = 0; bj < 2; ++bj) { const f32x4 v0 = acc[ai][bj][m][0], v1 = acc[ai][bj][m][1];
                        u32x4 w; w.x = cvt_pk_bf16(v0[0], v0[1]); w.y = cvt_pk_bf16(v0[2], v0[3]); w.z = cvt_pk_bf16(v1[0], v1[1]); w.w = cvt_pk_bf16(v1[2], v1[3]);
                        *(u32x4*)(rowp + bj * HALF) = w; } }
        } else if (wc < 2) {
            const int c0 = wc * 32 + 8 * fq;
#pragma unroll
            for (int ai = 0; ai < 2; ++ai)
#pragma unroll
                for (int m = 0; m < 4; ++m) { float* rowp = DT + (size_t)(row0 + ai * HALF + m * 16) * 64 + c0;
#pragma unroll
                    for (int n = 0; n < 2; ++n) { f32x4 v = acc[ai][0][m][n];
#pragma unroll
                        for (int j = 0; j < 4; ++j) v[j] = softplusf_(v[j] + dt_bias[c0 + 4 * n + j]);
                        *(f32x4*)(rowp + 4 * n) = v; } }
        }
    }
};
template <int SECOND> struct EpiBranch {
    static constexpr bool PERM = true, CHAIN = false;
    bf16_t* P;
    DI void operator()(const f32x4 (&acc)[2][2][4][2], const Unit& u, int wr, int wc, int fr, int fq) const {
        const int row0 = u.pm * BM + wr * 64 + fr, col0 = C_G + u.pn * BM + wc * 32 + 8 * fq;
#pragma unroll
        for (int aim = 0; aim < 4; ++aim) { const int ai = aim >> 1, m0 = (aim & 1) * 2;
            u32x4 gwv[4][2], pwv[4][2];
#pragma unroll
            for (int m = m0; m < m0 + 2; ++m) { const bf16_t* rowp = P + (size_t)(row0 + ai * HALF + m * 16) * LDP + col0;
#pragma unroll
                for (int bj = 0; bj < 2; ++bj) { gwv[m][bj] = *(const u32x4*)(rowp + bj * HALF + (SECOND ? DM : 0)); if (SECOND) pwv[m][bj] = *(const u32x4*)(rowp + bj * HALF); } }
#pragma unroll
            for (int m = m0; m < m0 + 2; ++m) { bf16_t* rowp = P + (size_t)(row0 + ai * HALF + m * 16) * LDP + col0;
#pragma unroll
                for (int bj = 0; bj < 2; ++bj) { const f32x4 v0 = acc[ai][bj][m][0], v1 = acc[ai][bj][m][1];
                    const u32x4 gw = gwv[m][bj];
                    float r[8];
                    r[0] = sigmoidf_(bflo(gw.x)) * v0[0]; r[1] = sigmoidf_(bfhi(gw.x)) * v0[1]; r[2] = sigmoidf_(bflo(gw.y)) * v0[2]; r[3] = sigmoidf_(bfhi(gw.y)) * v0[3];
                    r[4] = sigmoidf_(bflo(gw.z)) * v1[0]; r[5] = sigmoidf_(bfhi(gw.z)) * v1[1]; r[6] = sigmoidf_(bflo(gw.w)) * v1[2]; r[7] = sigmoidf_(bfhi(gw.w)) * v1[3];
                    if (SECOND) { const u32x4 pw = pwv[m][bj];
                        r[0] += bflo(pw.x); r[1] += bfhi(pw.x); r[2] += bflo(pw.y); r[3] += bfhi(pw.y); r[4] += bflo(pw.z); r[5] += bfhi(pw.z); r[6] += bflo(pw.w); r[7] += bfhi(pw.w); }
                    u32x4 w; w.x = cvt_pk_bf16(r[0], r[1]); w.y = cvt_pk_bf16(r[2], r[3]); w.z = cvt_pk_bf16(r[4], r[5]); w.w = cvt_pk_bf16(r[6], r[7]);
                    *(u32x4*)(rowp + bj * HALF) = w; } }
            asm volatile("" ::: "memory");
        }
    }
};
template <int INP> struct EpiResid {
    static constexpr bool PERM = false, CHAIN = false;
    const float* base; float* out; const float* mod; const float* b_mod; int goff;
    DI void operator()(const f32x4 (&acc)[2][2][4][2], const Unit& u, int wr, int wc, int fr, int fq) const {
        const int b = INP ? (u.pm >= 16 ? 1 : 0) : (u.pm >= 17 ? 1 : 0);
        const int lat0 = (INP ? u.pm * BM : u.pm * BM - 256 * (b + 1)) + wr * 64 + fr, col0 = u.pn * BM + wc * 32 + 4 * fq;
        f32x4 gv[2][2];
#pragma unroll
        for (int bj = 0; bj < 2; ++bj)
#pragma unroll
            for (int n = 0; n < 2; ++n) gv[bj][n] = *(const f32x4*)(mod + (size_t)b * NMOD + goff + col0 + bj * HALF + n * 16) + *(const f32x4*)(b_mod + goff + col0 + bj * HALF + n * 16);
#pragma unroll
        for (int aim = 0; aim < 4; ++aim) { const int ai = aim >> 1, m0 = (aim & 1) * 2;
            f32x4 bsv[4][2][2];
#pragma unroll
            for (int m = m0; m < m0 + 2; ++m) { const size_t off = (size_t)(lat0 + ai * HALF + m * 16) * DM + col0;
#pragma unroll
                for (int bj = 0; bj < 2; ++bj)
#pragma unroll
                    for (int n = 0; n < 2; ++n) bsv[m][bj][n] = *(const f32x4*)(base + off + bj * HALF + n * 16); }
#pragma unroll
            for (int m = m0; m < m0 + 2; ++m) { const size_t off = (size_t)(lat0 + ai * HALF + m * 16) * DM + col0;
#pragma unroll
                for (int bj = 0; bj < 2; ++bj)
#pragma unroll
                    for (int n = 0; n < 2; ++n) *(f32x4*)(out + off + bj * HALF + n * 16) = bsv[m][bj][n] + gv[bj][n] * acc[ai][bj][m][n]; }
            asm volatile("" ::: "memory");
        }
    }
};
struct EpiMerge {
    static constexpr bool PERM = true, CHAIN = true;
    bf16_t* P;
    static DI float eneg(float g) { return __builtin_amdgcn_exp2f(fminf(-1.4426950408889634f * g, 64.f)); }
    DI void mid(f32x4 (&acc)[2][2][4][2], const Unit& u, int wr, int wc, int fr, int fq) const {
        const int row0 = u.pm * BM + wr * 64 + fr, col0 = C_G + u.pn * BM + wc * 32 + 8 * fq;
#pragma unroll
        for (int aim = 0; aim < 4; ++aim) { const int ai = aim >> 1, m0 = (aim & 1) * 2;
            u32x4 g1v[4][2], g2v[4][2];
#pragma unroll
            for (int m = m0; m < m0 + 2; ++m) { const bf16_t* rowp = P + (size_t)(row0 + ai * HALF + m * 16) * LDP + col0;
#pragma unroll
                for (int bj = 0; bj < 2; ++bj) { g1v[m][bj] = *(const u32x4*)(rowp + bj * HALF); g2v[m][bj] = *(const u32x4*)(rowp + bj * HALF + DM); } }
#pragma unroll
            for (int m = m0; m < m0 + 2; ++m)
#pragma unroll
                for (int bj = 0; bj < 2; ++bj) { const u32x4 a = g1v[m][bj], c = g2v[m][bj];
                    const float g1[8] = {bflo(a.x), bfhi(a.x), bflo(a.y), bfhi(a.y), bflo(a.z), bfhi(a.z), bflo(a.w), bfhi(a.w)};
                    const float g2[8] = {bflo(c.x), bfhi(c.x), bflo(c.y), bfhi(c.y), bflo(c.z), bfhi(c.z), bflo(c.w), bfhi(c.w)};
#pragma unroll
                    for (int j = 0; j < 8; ++j) { const float ratio = (1.f + eneg(g2[j])) * __builtin_amdgcn_rcpf(1.f + eneg(g1[j])); acc[ai][bj][m][j >> 2][j & 3] *= ratio; } }
            asm volatile("" ::: "memory");
        }
    }
    DI void operator()(const f32x4 (&acc)[2][2][4][2], const Unit& u, int wr, int wc, int fr, int fq) const {
        const int row0 = u.pm * BM + wr * 64 + fr, col0 = C_G + (u.pn - 8) * BM + wc * 32 + 8 * fq;
#pragma unroll
        for (int aim = 0; aim < 4; ++aim) { const int ai = aim >> 1, m0 = (aim & 1) * 2;
            u32x4 g2v[4][2];
#pragma unroll
            for (int m = m0; m < m0 + 2; ++m) { const bf16_t* rowp = P + (size_t)(row0 + ai * HALF + m * 16) * LDP + col0;
#pragma unroll
                for (int bj = 0; bj < 2; ++bj) g2v[m][bj] = *(const u32x4*)(rowp + bj * HALF + DM); }
#pragma unroll
            for (int m = m0; m < m0 + 2; ++m) { bf16_t* rowp = P + (size_t)(row0 + ai * HALF + m * 16) * LDP + col0;
#pragma unroll
                for (int bj = 0; bj < 2; ++bj) { const u32x4 c = g2v[m][bj]; const f32x4 v0 = acc[ai][bj][m][0], v1 = acc[ai][bj][m][1];
                    const float g2[8] = {bflo(c.x), bfhi(c.x), bflo(c.y), bfhi(c.y), bflo(c.z), bfhi(c.z), bflo(c.w), bfhi(c.w)};
                    float r[8];
#pragma unroll
                    for (int j = 0; j < 8; ++j) r[j] = (j < 4 ? v0[j & 3] : v1[j & 3]) * __builtin_amdgcn_rcpf(1.f + eneg(g2[j]));
                    u32x4 w; w.x = cvt_pk_bf16(r[0], r[1]); w.y = cvt_pk_bf16(r[2], r[3]); w.z = cvt_pk_bf16(r[4], r[5]); w.w = cvt_pk_bf16(r[6], r[7]);
                    *(u32x4*)(rowp + bj * HALF) = w; } }
            asm volatile("" ::: "memory");
        }
    }
};
struct EpiSwiglu {
    static constexpr bool PERM = true, CHAIN = false;
    bf16_t* H;
    DI void operator()(const f32x4 (&acc)[2][2][4][2], const Unit& u, int wr, int wc, int fr, int fq) const {
        const int row0 = u.pm * BM + wr * 64 + fr, col0 = u.pn * HALF + wc * 32 + 8 * fq;
#pragma unroll
        for (int ai = 0; ai < 2; ++ai)
#pragma unroll
            for (int m = 0; m < 4; ++m) { bf16_t* rowp = H + (size_t)(row0 + ai * HALF + m * 16) * DFF + col0;
                const f32x4 g0 = acc[ai][0][m][0], g1 = acc[ai][0][m][1], u0 = acc[ai][1][m][0], u1 = acc[ai][1][m][1];
                u32x4 w; w.x = cvt_pk_bf16(siluf_(g0[0]) * u0[0], siluf_(g0[1]) * u0[1]); w.y = cvt_pk_bf16(siluf_(g0[2]) * u0[2], siluf_(g0[3]) * u0[3]);
                w.z = cvt_pk_bf16(siluf_(g1[0]) * u1[0], siluf_(g1[1]) * u1[1]); w.w = cvt_pk_bf16(siluf_(g1[2]) * u1[2], siluf_(g1[3]) * u1[3]);
                *(u32x4*)rowp = w; asm volatile("" ::: "memory"); }
    }
};
}

namespace att {
constexpr int D = 128, NW = 8, QBLK = 32, KVBLK = 64;
constexpr float SCALE = 0.088388347648318440f;
constexpr float THR = 8.f;
constexpr int LDQ = LDP, LDK = LDP, LDO = LDP;
constexpr size_t SHM_V = KVBLK * D * 2, SHM_K = KVBLK * D * 2, SHM_ATTN = 2 * SHM_V + 2 * SHM_K + NW * 64 * 4;
#define KSWZ(row, colB) ((row) * 256 + ((colB) ^ (((row) & 7) << 4)))
#define SBAR() __builtin_amdgcn_sched_barrier(0)
DI int crow(int r, int hi) { return (r & 3) + 8 * (r >> 2) + 4 * hi; }
DI unsigned cvtpk(float lo, float hi) { unsigned r; asm volatile("v_cvt_pk_bf16_f32 %0, %1, %2" : "=v"(r) : "v"(lo), "v"(hi)); return r; }
DI bf16x8 ld8(const bf16_t* p) { return *reinterpret_cast<const bf16x8*>(p); }
DI void partialSM(f32x16& p0, f32x16& p1, float& m_reg, float& mn, float& alpha) {
  constexpr float C = SCALE * 1.4426950408889634f;
  float pmax = p0[0]; for (int r = 1; r < 16; ++r) pmax = fmaxf(pmax, p0[r]); for (int r = 0; r < 16; ++r) pmax = fmaxf(pmax, p1[r]);
  { auto rr = __builtin_amdgcn_permlane32_swap(__float_as_uint(pmax), __float_as_uint(pmax), false, false);
    pmax = fmaxf(__uint_as_float(rr[0]), __uint_as_float(rr[1])); }
  if (__builtin_expect(__all(pmax - m_reg <= THR / SCALE), 1)) { mn = m_reg; alpha = 1.f; }
  else { mn = fmaxf(m_reg, pmax); alpha = __builtin_amdgcn_exp2f((m_reg - mn) * C); m_reg = mn; }
  float mnC = -mn * C;
  for (int r = 0; r < 16; ++r) p0[r] = fmaf(p0[r], C, mnC); for (int r = 0; r < 16; ++r) p1[r] = fmaf(p1[r], C, mnC);
  for (int r = 0; r < 16; ++r) p0[r] = __builtin_amdgcn_exp2f(p0[r]);
}
DI void finishSM(f32x16& p0, f32x16& p1, float alpha, float& l_reg, bf16x8& pa0, bf16x8& pa1, bf16x8& pa2, bf16x8& pa3) {
  for (int r = 0; r < 16; ++r) p1[r] = __builtin_amdgcn_exp2f(p1[r]);
  float ps = 0; for (int r = 0; r < 16; ++r) ps += p0[r]; for (int r = 0; r < 16; ++r) ps += p1[r];
  { auto rr = __builtin_amdgcn_permlane32_swap(__float_as_uint(ps), __float_as_uint(ps), false, false);
    ps = __uint_as_float(rr[0]) + __uint_as_float(rr[1]); }
  l_reg = l_reg * alpha + ps;
#define PK4(P, BASE, OUT) do { unsigned a0 = cvtpk(P[BASE + 0], P[BASE + 1]), a1 = cvtpk(P[BASE + 2], P[BASE + 3]);   \
    unsigned b0 = cvtpk(P[BASE + 4], P[BASE + 5]), b1 = cvtpk(P[BASE + 6], P[BASE + 7]);                              \
    auto r0 = __builtin_amdgcn_permlane32_swap(a0, b0, false, false); auto r1 = __builtin_amdgcn_permlane32_swap(a1, b1, false, false); \
    u32x4 w = {r0[0], r1[0], r0[1], r1[1]}; OUT = *reinterpret_cast<bf16x8*>(&w); } while (0)
  PK4(p0, 0, pa0); PK4(p0, 8, pa1); PK4(p1, 0, pa2); PK4(p1, 8, pa3);
#undef PK4
}
DI void qkt(f32x16& p0, f32x16& p1, const bf16_t* Ks, const bf16x8* qr, int r32, int hi) {
  p0 = f32x16{}; p1 = f32x16{};
  for (int d0 = 0; d0 < 8; ++d0) { int cb = (d0 * 16 + hi * 8) * 2;
    bf16x8 b0 = *reinterpret_cast<const bf16x8*>((const char*)Ks + KSWZ(r32, cb));
    bf16x8 b1 = *reinterpret_cast<const bf16x8*>((const char*)Ks + KSWZ(32 + r32, cb));
    p0 = __builtin_amdgcn_mfma_f32_32x32x16_bf16(b0, qr[d0], p0, 0, 0, 0);
    p1 = __builtin_amdgcn_mfma_f32_32x32x16_bf16(b1, qr[d0], p1, 0, 0, 0); }
}
DI int v_st(int k, int c) { const int kk = (k & ~0xC) | ((k & 4) << 1) | ((k & 8) >> 1); return ((kk >> 3) * 4 + (c >> 5)) * 512 + ((kk & 7) * 32 + (c & 31)) * 2; }
DI int v_rd_base(int lane) { return ((lane & 3) << 3) | (((lane >> 2) & 3) << 6) | (((lane >> 4) & 1) << 5) | (((lane >> 5) & 1) << 8); }
constexpr int v_rd_off(int d0, int ks, int half) { return d0 * 512 + ks * 4096 + half * 2048; }
template <int OFF> DI s16x4 tr_read(int vb) {
  s16x4 r; asm volatile("ds_read_b64_tr_b16 %0, %1 offset:%2" : "=&v"(r) : "v"(vb), "i"(OFF) : "memory"); return r;
}
template <int D0> DI void pv_one(f32x16& od, int vb, bf16x8 pa0, bf16x8 pa1, bf16x8 pa2, bf16x8 pa3) {
  const s16x4 l0 = tr_read<v_rd_off(D0, 0, 0)>(vb), h0 = tr_read<v_rd_off(D0, 0, 1)>(vb), l1 = tr_read<v_rd_off(D0, 1, 0)>(vb), h1 = tr_read<v_rd_off(D0, 1, 1)>(vb);
  const s16x4 l2 = tr_read<v_rd_off(D0, 2, 0)>(vb), h2 = tr_read<v_rd_off(D0, 2, 1)>(vb), l3 = tr_read<v_rd_off(D0, 3, 0)>(vb), h3 = tr_read<v_rd_off(D0, 3, 1)>(vb);
  asm volatile("s_waitcnt lgkmcnt(0)" ::: "memory"); SBAR();
#define PK(L, H) (bf16x8){L[0], L[1], L[2], L[3], H[0], H[1], H[2], H[3]}
  od = __builtin_amdgcn_mfma_f32_32x32x16_bf16(pa0, PK(l0, h0), od, 0, 0, 0);
  od = __builtin_amdgcn_mfma_f32_32x32x16_bf16(pa1, PK(l1, h1), od, 0, 0, 0);
  od = __builtin_amdgcn_mfma_f32_32x32x16_bf16(pa2, PK(l2, h2), od, 0, 0, 0);
  od = __builtin_amdgcn_mfma_f32_32x32x16_bf16(pa3, PK(l3, h3), od, 0, 0, 0);
#undef PK
}
DI void pv_d0(f32x16* o, int vb, bf16x8 pa0, bf16x8 pa1, bf16x8 pa2, bf16x8 pa3) {
  pv_one<0>(o[0], vb, pa0, pa1, pa2, pa3); pv_one<1>(o[1], vb, pa0, pa1, pa2, pa3); pv_one<2>(o[2], vb, pa0, pa1, pa2, pa3); pv_one<3>(o[3], vb, pa0, pa1, pa2, pa3);
}
DI void attn_dense_body(const bf16_t* __restrict__ Qb, const bf16_t* __restrict__ Kh, const bf16_t* __restrict__ Vh, bf16_t* Ob, int seq, char* lds, int tid, const float* __restrict__ qnw, int t0) {
  asm volatile("" : "+v"(tid));
  const int wid = tid >> 6, lane = tid & 63, r32 = lane & 31, hi = lane >> 5;
  bf16_t* V_lds = (bf16_t*)lds; bf16_t* K_lds = (bf16_t*)(lds + 2 * SHM_V);
  float* ws = (float*)(lds + 2 * SHM_V + 2 * SHM_K) + wid * 64; float* li_l = ws; float* al_l = ws + 32;
  float m_reg = -1e30f, l_reg = 0; f32x16 o[4] = {}; bf16x8 qr[8];
  const bf16_t* Qw = Qb + (long)(wid * QBLK + r32) * LDQ + hi * 8;
  {
    float qf[8][8]; float ssq = 0.f;
#pragma unroll
    for (int d0 = 0; d0 < 8; ++d0) { const u32x4 w = *reinterpret_cast<const u32x4*>(Qw + d0 * 16);
      qf[d0][0] = bflo(w.x); qf[d0][1] = bfhi(w.x); qf[d0][2] = bflo(w.y); qf[d0][3] = bfhi(w.y); qf[d0][4] = bflo(w.z); qf[d0][5] = bfhi(w.z); qf[d0][6] = bflo(w.w); qf[d0][7] = bfhi(w.w); }
#pragma unroll
    for (int d0 = 0; d0 < 8; ++d0)
#pragma unroll
      for (int j = 0; j < 8; ++j) ssq += qf[d0][j] * qf[d0][j];
    { auto rr = __builtin_amdgcn_permlane32_swap(__float_as_uint(ssq), __float_as_uint(ssq), false, false); ssq = __uint_as_float(rr[0]) + __uint_as_float(rr[1]); }
    const float rstd = rsqrtf(ssq * (1.f / 128.f) + EPS);
    const int tok = t0 + wid * QBLK + r32; const float posr = (float)(tok >> 6), posc = (float)(tok & 63);
#pragma unroll
    for (int d0 = 0; d0 < 8; ++d0) { const f32x4 wa = *reinterpret_cast<const f32x4*>(qnw + d0 * 16 + hi * 8), wb = *reinterpret_cast<const f32x4*>(qnw + d0 * 16 + hi * 8 + 4);
      qf[d0][0] *= rstd * wa[0]; qf[d0][1] *= rstd * wa[1]; qf[d0][2] *= rstd * wa[2]; qf[d0][3] *= rstd * wa[3]; qf[d0][4] *= rstd * wb[0]; qf[d0][5] *= rstd * wb[1]; qf[d0][6] *= rstd * wb[2]; qf[d0][7] *= rstd * wb[3]; }
#pragma unroll
    for (int q = 0; q < 4; ++q) { const int da = (q >> 1) * 4 + (q & 1), db = da + 2; const float pos = (q >> 1) ? posc : posr;
#pragma unroll
      for (int j = 0; j < 8; ++j) { const int f = (da & 1) * 16 + hi * 8 + j;
        float rev = pos * (exp2f(-(float)f * (13.287712379549449f / 32.f)) * 0.15915494309189535f); rev = rev - floorf(rev);
        const float cs = __builtin_amdgcn_cosf(rev), sn = __builtin_amdgcn_sinf(rev), n1 = qf[da][j], n2 = qf[db][j];
        qf[da][j] = n1 * cs - n2 * sn; qf[db][j] = n2 * cs + n1 * sn; } }
#pragma unroll
    for (int d0 = 0; d0 < 8; ++d0) { u32x4 w = {cvtpk(qf[d0][0], qf[d0][1]), cvtpk(qf[d0][2], qf[d0][3]), cvtpk(qf[d0][4], qf[d0][5]), cvtpk(qf[d0][6], qf[d0][7])}; qr[d0] = *reinterpret_cast<bf16x8*>(&w); }
  }
  const int sr = tid >> 4, sc = (tid & 15) * 8, vst0 = v_st(sr, sc), vst1 = v_st(32 + sr, sc);
  const int vb0 = (int)(uintptr_t)V_lds + v_rd_base(lane);
  constexpr int SDEPTH = 1;
  struct { bf16x8 vs0, vs1, ks0, ks1; } sr_[SDEPTH];
#define SLOAD(i, k0) do { sr_[i].vs0 = ld8(&Vh[(long)((k0) + sr) * LDK + sc]); sr_[i].vs1 = ld8(&Vh[(long)((k0) + 32 + sr) * LDK + sc]); \
    sr_[i].ks0 = ld8(&Kh[(long)((k0) + sr) * LDK + sc]); sr_[i].ks1 = ld8(&Kh[(long)((k0) + 32 + sr) * LDK + sc]); } while (0)
#define SWRITE(b, i) do { *(bf16x8*)((char*)V_lds + (b) * SHM_V + vst0) = sr_[i].vs0;          \
    *(bf16x8*)((char*)V_lds + (b) * SHM_V + vst1) = sr_[i].vs1; int kc = sc * 2;               \
    *(bf16x8*)((char*)K_lds + (b) * SHM_K + KSWZ(sr, kc)) = sr_[i].ks0;                       \
    *(bf16x8*)((char*)K_lds + (b) * SHM_K + KSWZ(32 + sr, kc)) = sr_[i].ks1; } while (0)
#define SWAIT() do { if constexpr (SDEPTH == 2) asm volatile("s_waitcnt vmcnt(4)" ::: "memory"); else asm volatile("s_waitcnt vmcnt(0)" ::: "memory"); } while (0)
#define RESC(a) do { if (__any((a) < 1.f)) { if (hi == 0) al_l[r32] = (a); asm volatile("s_waitcnt lgkmcnt(0)" ::: "memory"); \
    for (int d = 0; d < 4; ++d) for (int r = 0; r < 16; ++r) o[d][r] *= al_l[crow(r, hi)]; } } while (0)
  f32x16 pA0, pA1, pB0, pB1; float mnA, mnB, alA, alB; bf16x8 pa0, pa1, pa2, pa3; const int NT = seq / KVBLK;
  constexpr int SE = 0, SO = SDEPTH - 1;
  SLOAD(SE, 0); asm volatile("s_waitcnt vmcnt(0)" ::: "memory"); SWRITE(0, SE); __syncthreads();
  qkt(pA0, pA1, K_lds, qr, r32, hi); partialSM(pA0, pA1, m_reg, mnA, alA);
  SLOAD(SO, KVBLK); if constexpr (SDEPTH == 2) { if (2 < NT) SLOAD(SE, 2 * KVBLK); }
  SWAIT(); SWRITE(1, SO); __syncthreads();
  for (int j = 1; j + 1 < NT; j += 2) {
    SBAR(); qkt(pB0, pB1, (bf16_t*)((char*)K_lds + SHM_K), qr, r32, hi);
    finishSM(pA0, pA1, alA, l_reg, pa0, pa1, pa2, pa3); SBAR();
    SLOAD(SO, (j + SDEPTH) * KVBLK); SBAR();
    pv_d0(o, vb0, pa0, pa1, pa2, pa3); partialSM(pB0, pB1, m_reg, mnB, alB);
    __syncthreads(); SWAIT(); SWRITE(0, SE);
    RESC(alB); __syncthreads();
    SBAR(); qkt(pA0, pA1, K_lds, qr, r32, hi);
    finishSM(pB0, pB1, alB, l_reg, pa0, pa1, pa2, pa3); SBAR();
    if (SDEPTH == 1 || j + 3 < NT) SLOAD(SE, (j + 1 + SDEPTH) * KVBLK); SBAR();
    pv_d0(o, vb0 + (int)SHM_V, pa0, pa1, pa2, pa3); partialSM(pA0, pA1, m_reg, mnA, alA);
    __syncthreads(); SWAIT(); SWRITE(1, SO);
    RESC(alA); __syncthreads();
  }
  SBAR(); qkt(pB0, pB1, (bf16_t*)((char*)K_lds + SHM_K), qr, r32, hi);
  finishSM(pA0, pA1, alA, l_reg, pa0, pa1, pa2, pa3); SBAR();
  pv_d0(o, vb0, pa0, pa1, pa2, pa3); partialSM(pB0, pB1, m_reg, mnB, alB);
  __syncthreads(); RESC(alB);
  finishSM(pB0, pB1, alB, l_reg, pa0, pa1, pa2, pa3); SBAR();
  pv_d0(o, vb0 + (int)SHM_V, pa0, pa1, pa2, pa3);
  if (hi == 0) li_l[r32] = l_reg; asm volatile("s_waitcnt lgkmcnt(0)" ::: "memory");
  float rli[16];
#pragma unroll
  for (int r = 0; r < 16; ++r) rli[r] = __builtin_amdgcn_rcpf(li_l[crow(r, hi)]);
  bf16_t* Ow = Ob + (long)(wid * QBLK) * LDO;
#pragma unroll
  for (int r = 0; r < 16; ++r) { int orow = crow(r, hi);
    for (int d0 = 0; d0 < 4; ++d0) Ow[(long)orow * LDO + d0 * 32 + r32] = f2bf(o[d0][r] * rli[r]); }
#undef SLOAD
#undef SWRITE
#undef SWAIT
#undef RESC
}
}

#define XB_TMO      128
#define XB_XCNT(j)  (256  + 64 * (j))
#define XB_XSUB(j)  (1280 + 64 * (j))
#define XB_XGEN(j)  (2304 + 64 * (j))
#define XB_TOP      3328
#define XB_TOPGEN   3392
#define XCD_BAR_WORDS 3456
#define XB_SPIN_CAP (1u << 18)
DI unsigned xb_ld(unsigned* p)              { return __hip_atomic_load(p, __ATOMIC_RELAXED, __HIP_MEMORY_SCOPE_AGENT); }
DI unsigned xb_add(unsigned* p, unsigned v) { return __hip_atomic_fetch_add(p, v, __ATOMIC_RELAXED, __HIP_MEMORY_SCOPE_AGENT); }
DI unsigned xb_xcc_id() { return (unsigned)__builtin_amdgcn_s_getreg((3 << 11) | 20) & 0xFu; }
#define XB_SPIN(cond, bar) do { unsigned _sp = 0; while (cond) { __builtin_amdgcn_s_sleep(1); \
    if ((++_sp & 255u) == 0u) { if (xb_ld(&(bar)[XB_TMO])) break; if (_sp > XB_SPIN_CAP) { atomicAdd(&(bar)[XB_TMO], 1u); break; } } } } while (0)
struct XcdBarrier { unsigned* bar; unsigned x; volatile LAS unsigned* st; };
DI XcdBarrier xcd_barrier_post(unsigned* bar, volatile LAS unsigned* st) {
    XcdBarrier b; b.bar = bar; b.x = xb_xcc_id(); b.st = st;
    if (threadIdx.x == 0) (void)xb_add(&bar[XB_XCNT(b.x)], 1u);
    return b;
}
DI void xcd_barrier_complete(unsigned* bar, unsigned x, unsigned& nloc, unsigned& nx) {
    const unsigned G = gridDim.x * gridDim.y * gridDim.z;
    unsigned sum, cnt, mine, sp = 0u;
    for (;;) {
        sum = 0u; cnt = 0u; mine = 0u;
#pragma unroll
        for (unsigned j = 0; j < 16; ++j) { const unsigned c = xb_ld(&bar[XB_XCNT(j)]); sum += c; cnt += (c > 0u) ? 1u : 0u; mine = (j == x) ? c : mine; }
        if (sum == G) break;
        __builtin_amdgcn_s_sleep(1);
        if ((++sp & 255u) == 0u) { if (xb_ld(&bar[XB_TMO])) break; if (sp > XB_SPIN_CAP) { atomicAdd(&bar[XB_TMO], 1u); break; } }
    }
    nloc = mine > 0u ? mine : 1u; nx = cnt > 0u ? cnt : 1u;
}
DI void xcd_barrier(const XcdBarrier& b, bool leader) {
    asm volatile("s_waitcnt vmcnt(0)" ::: "memory");
    __syncthreads();
    if (leader) {
        unsigned* bar = b.bar;
        __builtin_amdgcn_s_waitcnt(0);
        unsigned nloc = b.st[0], nx = b.st[1];
        if (nloc == 0u) { xcd_barrier_complete(bar, b.x, nloc, nx); b.st[0] = nloc; b.st[1] = nx; }
        const unsigned old = xb_add(&bar[XB_XSUB(b.x)], 1u);
        const unsigned gen = old / nloc;
        if (old + 1u == (gen + 1u) * nloc) {
            __builtin_amdgcn_fence(__ATOMIC_RELEASE, "agent");
            asm volatile("s_waitcnt vmcnt(0)" ::: "memory");
            const unsigned og = xb_add(&bar[XB_TOP], 1u);
            const unsigned tg = og / nx;
            if (og + 1u == (tg + 1u) * nx) xb_add(&bar[XB_TOPGEN], 1u);
            else XB_SPIN(xb_ld(&bar[XB_TOPGEN]) == tg, bar);
            __builtin_amdgcn_fence(__ATOMIC_ACQUIRE, "agent");
            xb_add(&bar[XB_XGEN(b.x)], 1u);
            asm volatile("s_waitcnt vmcnt(0)" ::: "memory");
        } else {
            XB_SPIN(xb_ld(&bar[XB_XGEN(b.x)]) == gen, bar);
            __builtin_amdgcn_fence(__ATOMIC_ACQUIRE, "agent");
            asm volatile("s_waitcnt vmcnt(0)" ::: "memory");
        }
    }
    __syncthreads();
}
static_assert(XCD_BAR_WORDS * 4 <= WS_MOD, "barrier words fit the zeroed control region");

struct Args { const float* in[22]; float* out; unsigned char* ws; int ph_lo, ph_hi; };
enum { I_X = 0, I_C, I_CTX, I_CCTX, I_WMOD, I_BMOD, I_NORM1, I_WIN, I_CONVW, I_CONVB, I_DTB, I_ALOG, I_DSKIP, I_SSMN, I_QN, I_KN, I_WSSM, I_WATT, I_WO, I_NORM2, I_WF1, I_WF2 };

DI void transpose_item(const float* src, int ldw, bf16_t* dst, int ldt, char* scr, int lane) {
    if (src == nullptr) {
#pragma unroll
        for (int i = 0; i < 8; ++i) { const int n = i * 8 + (lane >> 3), k = (lane & 7) * 8; *(u32x4*)(dst + (size_t)n * ldt + k) = (u32x4){0u, 0u, 0u, 0u}; }
        return;
    }
    f32x4 v[16];
#pragma unroll
    for (int i = 0; i < 16; ++i) { const int k = i * 4 + (lane >> 4), n = (lane & 15) * 4; v[i] = *(const f32x4*)(src + (size_t)k * ldw + n); }
#pragma unroll
    for (int i = 0; i < 16; ++i) { const int k = i * 4 + (lane >> 4), n = (lane & 15) * 4;
        *(unsigned*)(scr + (k * 66 + n) * 2) = cvt_pk_bf16(v[i][0], v[i][1]); *(unsigned*)(scr + (k * 66 + n + 2) * 2) = cvt_pk_bf16(v[i][2], v[i][3]); }
    asm volatile("s_waitcnt lgkmcnt(0)" ::: "memory");
#pragma unroll
    for (int i = 0; i < 8; ++i) { const int n = i * 8 + (lane >> 3), k = (lane & 7) * 8;
        unsigned short e[8];
#pragma unroll
        for (int j = 0; j < 8; ++j) e[j] = *(const unsigned short*)(scr + ((k + j) * 66 + n) * 2);
        u32x4 w; w.x = e[0] | ((unsigned)e[1] << 16); w.y = e[2] | ((unsigned)e[3] << 16); w.z = e[4] | ((unsigned)e[5] << 16); w.w = e[6] | ((unsigned)e[7] << 16);
        *(u32x4*)(dst + (size_t)n * ldt + k) = w; }
    asm volatile("s_waitcnt lgkmcnt(0)" ::: "memory");
}
template <class F> DI void transpose_matrix(const float* W, int K, int N, bf16_t* Wt, int nd, F srccol, char* scr, int gw, int ngw, int lane) {
    const int kb = K / 64, items = (nd / 64) * kb;
    for (int it = gw; it < items; it += ngw) { const int db = it / kb, k0 = (it % kb) * 64; const int sc = srccol(db);
        transpose_item(sc < 0 ? nullptr : W + (size_t)k0 * N + sc, N, Wt + (size_t)db * 64 * K + k0, K, scr, lane); }
}

DI int rm_off(int row, int col) { return row * 272 + col * 2; }
DI int tr_off(int row, int col) { return row * 272 + ((((col >> 3) ^ (row >> 3)) & 15) << 4) + ((col & 7) << 1); }
#define MFMA32(a, b, c) __builtin_amdgcn_mfma_f32_32x32x16_bf16((a), (b), (c), 0, 0, 0)

__global__ void __launch_bounds__(NTHR, 2) fwd_megakernel(Args args) {
    extern __shared__ __attribute__((aligned(16))) unsigned char lds_raw[];
    cg::grid_group grid = cg::this_grid();
    char* lds = (char*)lds_raw;
    const int G = gridDim.x, bid = blockIdx.x, ngw = G * NWAVES;
    const int wave_s = __builtin_amdgcn_readfirstlane((int)threadIdx.x >> 6);
#define PHASE_VARS int tid = wave_s * 64 + (int)__builtin_amdgcn_mbcnt_hi(~0u, __builtin_amdgcn_mbcnt_lo(~0u, 0u)); asm volatile("" : "+v"(tid)); const int lane = tid & 63, wave = tid >> 6, gw = bid * NWAVES + wave; (void)lane; (void)wave; (void)gw; unsigned char* ws = args.ws; asm volatile("" : "+s"(ws));
    unsigned char* ws0 = args.ws;
#define PHASE_PTRS const float* x = args.in[I_X]; const float* b_mod = args.in[I_BMOD]; \
    float* MOD = (float*)(ws + WS_MOD); float* DT = (float*)(ws + WS_DT); float* DEC = (float*)(ws + WS_DEC); \
    bf16_t* P = (bf16_t*)(ws + WS_P); bf16_t* XBC = (bf16_t*)(ws + WS_XBC); bf16_t* ST = (bf16_t*)(ws + WS_ST); \
    (void)x; (void)b_mod; (void)MOD; (void)DT; (void)DEC; (void)P; (void)XBC; (void)ST; (void)ws0;
    const int lo = args.ph_lo, hi = args.ph_hi;
#ifndef PH_MASK
#define PH_MASK 0xFFFF
#endif
#define IN(k) (((PH_MASK >> (k)) & 1) && ((k) == 13 || (lo <= (k) && (k) < hi)))
#ifndef PROBE_MASK
#define PROBE_MASK 0
#endif
#ifndef PROBE_MULT
#define PROBE_MULT 4
#endif
    volatile LAS unsigned* misc = (volatile LAS unsigned*)(lds_raw + LDS_BYTES - 32);
    if (threadIdx.x == 0) { misc[0] = 0u; misc[1] = 0u; misc[2] = 0u; misc[3] = 0u; }
    __syncthreads();
    XcdBarrier xbar = xcd_barrier_post((unsigned*)(ws0 + WS_CTL), misc);
    if (lo < 0) grid.sync();
#define PROBE_BEGIN(k) do { if (((PROBE_MASK >> (k)) & 1) && bid == 0 && threadIdx.x == 0) misc[2] = (unsigned)__builtin_amdgcn_s_memrealtime(); } while (0)
#define PROBE_END(k) do { if (((PROBE_MASK >> (k)) & 1) && bid == 0 && threadIdx.x == 0) misc[3] = misc[3] + ((unsigned)__builtin_amdgcn_s_memrealtime() - misc[2]); } while (0)
#define SEAM(k) do { if (IN(k) && IN((k) + 1)) xcd_barrier(xbar, wave_s == 0 && __builtin_amdgcn_mbcnt_hi(~0u, __builtin_amdgcn_mbcnt_lo(~0u, 0u)) == 0u); PROBE_END(k); } while (0)

    if (IN(0)) { PROBE_BEGIN(0); PHASE_VARS PHASE_PTRS
        char* scr = lds + wave * 8448;
        transpose_matrix(args.in[I_WIN], DM, 13376, (bf16_t*)(ws + WS_WIN), LDP, [](int db) { const int n = db * 64; return n < 6144 ? n : (n < 13312 ? n + 64 : (n < 13376 ? n - 13312 + 6144 : -1)); }, scr, gw, ngw, lane);
        __syncthreads();
        float* sv = (float*)lds;
        for (int it = bid; it < 256; it += G) {
            const int ng = it & 7, kg = it >> 3;
            __syncthreads();
            if (tid < 192) { const int v = tid >> 6, kk = tid & 63, k = kg * 64 + kk; const float cv = v < 2 ? args.in[I_C][v * DM + k] : args.in[I_CCTX][k]; sv[tid] = siluf_(cv); }
            __syncthreads();
            if (tid < 384) {
                const int col = ng * 1536 + tid * 4; const float* wp = args.in[I_WMOD] + (size_t)(kg * 64) * NMOD + col;
                f32x4 a0 = {0.f, 0.f, 0.f, 0.f}, a1 = a0, a2 = a0;
#pragma unroll 8
                for (int kk = 0; kk < 64; ++kk) { const f32x4 w = *(const f32x4*)(wp + (size_t)kk * NMOD); a0 += w * sv[kk]; a1 += w * sv[64 + kk]; a2 += w * sv[128 + kk]; }
#pragma unroll
                for (int j = 0; j < 4; ++j) { atomicAdd(MOD + col + j, a0[j]); atomicAdd(MOD + NMOD + col + j, a1[j]); atomicAdd(MOD + 2 * NMOD + col + j, a2[j]); }
            }
        }
    }
    SEAM(0);

    if (IN(1)) { PROBE_BEGIN(1); PHASE_VARS PHASE_PTRS
        bf16_t* XN = (bf16_t*)(ws + WS_XN); const float* norm1 = args.in[I_NORM1];
        float* pl = (float*)lds;
        const int rpb = (MP + G - 1) / G;
        for (int r0 = bid * rpb; r0 < MP; r0 += G * rpb) {
            const int b = r0 / RPB;
            __syncthreads();
            for (int i = tid; i < 2 * DM; i += NTHR) { const int var = i >> 11, col = i & (DM - 1); const float* mv = MOD + (size_t)(var ? 2 : b) * NMOD;
                const float nw = norm1[col]; pl[var * 4096 + col] = nw * (mv[DM + col] + b_mod[DM + col] + 1.f); pl[var * 4096 + 2048 + col] = mv[col] + b_mod[col]; }
            __syncthreads();
            const int rend = (r0 + rpb < MP) ? r0 + rpb : MP;
            for (int r = r0 + wave; r < rend; r += NWAVES) {
                const int rb = r / RPB, t = r % RPB; const int var = t < CTXL ? 1 : 0;
                const float* src = t < CTXL ? args.in[I_CTX] + (size_t)(rb * CTXL + t) * DM : x + (size_t)(rb * SEQ + t - CTXL) * DM;
                f32x4 xv[8]; float ss = 0.f;
#pragma unroll
                for (int j = 0; j < 8; ++j) xv[j] = *(const f32x4*)(src + j * 256 + lane * 4);
#pragma unroll
                for (int j = 0; j < 8; ++j) ss += xv[j][0] * xv[j][0] + xv[j][1] * xv[j][1] + xv[j][2] * xv[j][2] + xv[j][3] * xv[j][3];
                const float rstd = rsqrtf(wave_sum(ss) * (1.f / DM) + EPS);
                if (rb == b) {
#pragma unroll
                    for (int j = 0; j < 8; ++j) { const int col = j * 256 + lane * 4;
                        const f32x4 o = xv[j] * rstd * *(const f32x4*)(pl + var * 4096 + col) + *(const f32x4*)(pl + var * 4096 + 2048 + col);
                        u32x2 w; w.x = cvt_pk_bf16(o[0], o[1]); w.y = cvt_pk_bf16(o[2], o[3]);
                        *(u32x2*)(XN + (size_t)r * DM + col) = w; }
                } else {
                    const float* mv = MOD + (size_t)(var ? 2 : rb) * NMOD;
#pragma unroll
                    for (int j = 0; j < 8; ++j) { const int col = j * 256 + lane * 4;
                        const f32x4 nw = *(const f32x4*)(norm1 + col), sh = *(const f32x4*)(mv + col) + *(const f32x4*)(b_mod + col), sc = *(const f32x4*)(mv + DM + col) + *(const f32x4*)(b_mod + DM + col);
                        const f32x4 o = xv[j] * rstd * nw * (sc + 1.f) + sh;
                        u32x2 w; w.x = cvt_pk_bf16(o[0], o[1]); w.y = cvt_pk_bf16(o[2], o[3]);
                        *(u32x2*)(XN + (size_t)r * DM + col) = w; }
                }
            }
        }
    }
    SEAM(1);

    if (IN(2)) { PROBE_BEGIN(2); PHASE_VARS PHASE_PTRS
        pg8::Gemm g{(const bf16_t*)(ws + WS_XN), (const bf16_t*)(ws + WS_WIN), DM, DM, DM};
        pg8::Sched S; S.init(32, 53, G, bid, 2);
        pg8::EpiInProj E{P, DT, args.in[I_DTB]};
        pg8::gemm_phase<pg8::EpiInProj>((LAS unsigned char*)lds_raw, g, S, E, tid);
        {
            const int rounds = (S.total + G - 1) / G, last_cnt = S.total - (rounds - 1) * G, n_idle = G - last_cnt;
            const bool idle = n_idle > 0 ? (bid >= last_cnt) : true;
            if (idle) {
                const int gwi = n_idle > 0 ? (bid - last_cnt) * NWAVES + wave : gw, ngwi = n_idle > 0 ? n_idle * NWAVES : ngw;
                char* scr = lds + wave * 8448;
                transpose_matrix(args.in[I_WSSM], DM, DM, (bf16_t*)(ws + WS_WSSM), DM, [](int db) { return db * 64; }, scr, gwi, ngwi, lane);
                transpose_matrix(args.in[I_WATT], DM, DM, (bf16_t*)(ws + WS_WATT), DM, [](int db) { return db * 64; }, scr, gwi, ngwi, lane);
                transpose_matrix(args.in[I_WO], DM, DM, (bf16_t*)(ws + WS_WO), DM, [](int db) { return db * 64; }, scr, gwi, ngwi, lane);
            }
        }
    }
    SEAM(2);

    if (IN(3)) { PROBE_BEGIN(3); PHASE_VARS PHASE_PTRS
        const float* cw = args.in[I_CONVW]; const float* cb = args.in[I_CONVB];
        const int gt = bid * NTHR + tid, ngt = G * NTHR;
        float w[5][8], bias[8];
        { const int ch = (gt & 511) * 8;
#pragma unroll
            for (int j = 0; j < 5; ++j) { const f32x4 a = *(const f32x4*)(cw + j * 4096 + ch), c2 = *(const f32x4*)(cw + j * 4096 + ch + 4);
                w[j][0] = a[0]; w[j][1] = a[1]; w[j][2] = a[2]; w[j][3] = a[3]; w[j][4] = c2[0]; w[j][5] = c2[1]; w[j][6] = c2[2]; w[j][7] = c2[3]; }
            { const f32x4 a = *(const f32x4*)(cb + ch), c2 = *(const f32x4*)(cb + ch + 4); bias[0] = a[0]; bias[1] = a[1]; bias[2] = a[2]; bias[3] = a[3]; bias[4] = c2[0]; bias[5] = c2[1]; bias[6] = c2[2]; bias[7] = c2[3]; } }
        for (int it = gt; it < 512 * 512; it += ngt) {
            const int cg8 = it & 511, rb = it >> 9, ch = cg8 * 8, r0 = rb * 17;
            const bf16_t* src = P + C_XBC + ch;
            u32x4 rw[21];
#pragma unroll
            for (int k = 0; k < 21; ++k) { const int rr = r0 - 2 + k; rw[k] = (rr >= 0 && rr < MP) ? *(const u32x4*)(src + (size_t)rr * LDP) : (u32x4){0u, 0u, 0u, 0u}; }
#pragma unroll
            for (int i = 0; i < 17; ++i) {
                const int ro = r0 + i; const int so = (ro / RPB) * 2 + ((ro % RPB) >= CTXL ? 1 : 0);
                float o[8];
#pragma unroll
                for (int e = 0; e < 8; ++e) o[e] = bias[e];
#pragma unroll
                for (int j = 0; j < 5; ++j) { const int rt = ro + j - 2; const int rtc = rt < 0 ? 0 : rt;
                    const bool ok = rt >= 0 && rt < MP && ((rtc / RPB) * 2 + ((rtc % RPB) >= CTXL ? 1 : 0)) == so;
                    if (ok) { const u32x4 q = rw[i + j];
                        o[0] += w[j][0] * bflo(q.x); o[1] += w[j][1] * bfhi(q.x); o[2] += w[j][2] * bflo(q.y); o[3] += w[j][3] * bfhi(q.y);
                        o[4] += w[j][4] * bflo(q.z); o[5] += w[j][5] * bfhi(q.z); o[6] += w[j][6] * bflo(q.w); o[7] += w[j][7] * bfhi(q.w); } }
                u32x4 ov; ov.x = cvt_pk_bf16(siluf_(o[0]), siluf_(o[1])); ov.y = cvt_pk_bf16(siluf_(o[2]), siluf_(o[3])); ov.z = cvt_pk_bf16(siluf_(o[4]), siluf_(o[5])); ov.w = cvt_pk_bf16(siluf_(o[6]), siluf_(o[7]));
                *(u32x4*)(XBC + (size_t)ro * 4096 + ch) = ov;
            }
        }
        const int sec = lane >> 5, f = lane & 31, e0 = sec * 64 + f, e1 = e0 + 32;
        const float qn0 = args.in[I_QN][e0], qn1 = args.in[I_QN][e1], kn0 = args.in[I_KN][e0], kn1 = args.in[I_KN][e1];
        const float inv_rev = exp2f(-(float)f * (13.287712379549449f / 32.f)) * 0.15915494309189535f;
        for (int r = gw; r < MP; r += ngw) {
            const int t = r % RPB; const bool lat = t >= CTXL; const int tl = t - CTXL;
            float cs = 1.f, sn = 0.f;
            if (lat) { const float pos = (float)(sec == 0 ? (tl >> 6) : (tl & 63)); float rev = pos * inv_rev; rev = rev - floorf(rev); cs = __builtin_amdgcn_cosf(rev); sn = __builtin_amdgcn_sinf(rev); }
            bf16_t* rowp = P + (size_t)r * LDP;
            if (lat) {
                float v0[4], v1[4], ss[4];
#pragma unroll
                for (int k = 0; k < 4; ++k) { const bf16_t* hp = rowp + C_K + k * 128; v0[k] = bf2f(hp[e0]); v1[k] = bf2f(hp[e1]); ss[k] = v0[k] * v0[k] + v1[k] * v1[k]; }
#pragma unroll
                for (int o = 32; o >= 1; o >>= 1) {
#pragma unroll
                    for (int k = 0; k < 4; ++k) ss[k] += __shfl_xor(ss[k], o); }
#pragma unroll
                for (int k = 0; k < 4; ++k) { bf16_t* hp = rowp + C_K + k * 128;
                    const float rstd = rsqrtf(ss[k] * (1.f / 128.f) + EPS);
                    const float n0 = v0[k] * rstd * kn0, n1 = v1[k] * rstd * kn1;
                    hp[e0] = f2bf(n0 * cs - n1 * sn); hp[e1] = f2bf(n1 * cs + n0 * sn); }
            } else {
                float v0[4], v1[4], ss[4];
#pragma unroll
                for (int k = 0; k < 4; ++k) { const bf16_t* hp = rowp + C_K + k * 128; v0[k] = bf2f(hp[e0]); v1[k] = bf2f(hp[e1]); ss[k] = v0[k] * v0[k] + v1[k] * v1[k]; }
#pragma unroll
                for (int k = 0; k < 4; ++k) ss[k] = wave_sum(ss[k]);
#pragma unroll
                for (int k = 0; k < 4; ++k) { bf16_t* hp = rowp + C_K + k * 128; const float rstd = rsqrtf(ss[k] * (1.f / 128.f) + EPS);
                    hp[e0] = f2bf(v0[k] * rstd * kn0); hp[e1] = f2bf(v1[k] * rstd * kn1); }
            }
        }
    }
    SEAM(3);

    if (IN(4)) { PROBE_BEGIN(4); PHASE_VARS PHASE_PTRS
        char* BT = lds;
        char* XT = lds + 34816;
        float* dtv = (float*)(lds + 104448);
        float* wv = dtv + 1024;
        const float* a_log = args.in[I_ALOG];
        for (int it = bid; it < NB * NSLOT * 8; it += G) {
            const int g = it & 7, slot = (it >> 3) % NSLOT, b = it / (8 * NSLOT); const int row0 = b * RPB + slot * 128;
            __syncthreads();
#pragma unroll
            for (int i = 0; i < 4; ++i) { const int idx = tid + i * NTHR, l = idx >> 4, n0 = (idx & 15) * 8;
                const u32x4 q = *(const u32x4*)(XBC + (size_t)(row0 + l) * 4096 + 2048 + g * 128 + n0);
                const unsigned short e[8] = {(unsigned short)q.x, (unsigned short)(q.x >> 16), (unsigned short)q.y, (unsigned short)(q.y >> 16), (unsigned short)q.z, (unsigned short)(q.z >> 16), (unsigned short)q.w, (unsigned short)(q.w >> 16)};
#pragma unroll
                for (int j = 0; j < 8; ++j) *(unsigned short*)(BT + tr_off(n0 + j, l)) = e[j]; }
#pragma unroll
            for (int i = 0; i < 8; ++i) { const int idx = tid + i * NTHR, l = idx >> 5, p0 = (idx & 31) * 8;
                const u32x4 q = *(const u32x4*)(XBC + (size_t)(row0 + l) * 4096 + g * 256 + p0);
                const unsigned short e[8] = {(unsigned short)q.x, (unsigned short)(q.x >> 16), (unsigned short)q.y, (unsigned short)(q.y >> 16), (unsigned short)q.z, (unsigned short)(q.z >> 16), (unsigned short)q.w, (unsigned short)(q.w >> 16)};
#pragma unroll
                for (int j = 0; j < 8; ++j) *(unsigned short*)(XT + tr_off(p0 + j, l)) = e[j]; }
#pragma unroll
            for (int i = 0; i < 2; ++i) { const int idx = tid + i * NTHR, hd = idx >> 7, l = idx & 127, dir = hd >> 2, hh = hd & 3;
                dtv[idx] = DT[(size_t)(row0 + l) * 64 + dir * 32 + g * 4 + hh]; }
            __syncthreads();
            { const int hd = wave, dir = hd >> 2, hh = hd & 3; const float A = -__expf(a_log[dir * 32 + g * 4 + hh]);
              float le0, le1, tot, a0, a1; wave_scan128(dtv + hd * 128, lane, le0, le1, tot, a0, a1);
              const float e0 = dir == 0 ? tot - le0 : le0 - a0, e1 = dir == 0 ? tot - le1 : le1 - a1;
              *(f32x2*)(wv + hd * 128 + 2 * lane) = (f32x2){__expf(e0 * A) * a0, __expf(e1 * A) * a1};
              if (lane == 0) DEC[((size_t)(b * 2 + dir) * NSLOT + slot) * 32 + g * 4 + hh] = __expf(tot * A); }
            __syncthreads();
            const int hh = wave >> 1, dir = wave & 1, hd = dir * 4 + hh, r = lane & 31, h = lane >> 5;
            f32x16 acc[2][4];
#pragma unroll
            for (int a = 0; a < 2; ++a)
#pragma unroll
                for (int c = 0; c < 4; ++c) acc[a][c] = f32x16{};
#pragma unroll 2
            for (int ks = 0; ks < 8; ++ks) {
                const int k0 = ks * 16 + 8 * h;
                const f32x4 w0 = *(const f32x4*)(wv + hd * 128 + k0), w1 = *(const f32x4*)(wv + hd * 128 + k0 + 4);
                bf16x8 xf[2], bfr[4];
#pragma unroll
                for (int tp = 0; tp < 2; ++tp) { const u32x4 q = *(const u32x4*)(XT + tr_off(hh * 64 + tp * 32 + r, k0));
                    u32x4 o; o.x = cvt_pk_bf16(bflo(q.x) * w0[0], bfhi(q.x) * w0[1]); o.y = cvt_pk_bf16(bflo(q.y) * w0[2], bfhi(q.y) * w0[3]);
                    o.z = cvt_pk_bf16(bflo(q.z) * w1[0], bfhi(q.z) * w1[1]); o.w = cvt_pk_bf16(bflo(q.w) * w1[2], bfhi(q.w) * w1[3]);
                    xf[tp] = __builtin_bit_cast(bf16x8, o); }
#pragma unroll
                for (int tn = 0; tn < 4; ++tn) bfr[tn] = *(const bf16x8*)(BT + tr_off(tn * 32 + r, k0));
#pragma unroll
                for (int tp = 0; tp < 2; ++tp)
#pragma unroll
                    for (int tn = 0; tn < 4; ++tn) acc[tp][tn] = MFMA32(bfr[tn], xf[tp], acc[tp][tn]);
            }
            bf16_t* sp = ST + ((size_t)(b * 2 + dir) * NSLOT + slot) * PLANE + (size_t)(g * 4 + hh) * 64 * 128;
#pragma unroll
            for (int tp = 0; tp < 2; ++tp)
#pragma unroll
                for (int tn = 0; tn < 4; ++tn)
#pragma unroll
                    for (int q = 0; q < 4; ++q) { const f32x16& a = acc[tp][tn];
                        u32x2 w; w.x = cvt_pk_bf16(a[4 * q], a[4 * q + 1]); w.y = cvt_pk_bf16(a[4 * q + 2], a[4 * q + 3]);
                        *(u32x2*)(sp + (size_t)(tp * 32 + r) * 128 + tn * 32 + 8 * q + 4 * h) = w; }
        }
    }
    SEAM(4);

    if (IN(5)) { PROBE_BEGIN(5); PHASE_VARS PHASE_PTRS
        const int gt = bid * NTHR + tid, ngt = G * NTHR;
        for (int it = gt; it < NB * 2 * 32 * 64 * 16; it += ngt) {
            const int e = (it & 32767) * 8, head = (it >> 10) & 31, bd = it >> 15, dir = bd & 1;
            bf16_t* base = ST + (size_t)bd * NSLOT * PLANE + e; const float* dec = DEC + (size_t)bd * NSLOT * 32 + head;
            float run[8] = {0.f, 0.f, 0.f, 0.f, 0.f, 0.f, 0.f, 0.f};
#pragma unroll
            for (int half = 0; half < 2; ++half) {
                u32x4 v[17]; float dc[17];
#pragma unroll
                for (int s = 0; s < 17; ++s) { const int step = half * 17 + s; const int slot = dir == 0 ? step : (step == 0 ? 1 : (step == 1 ? 0 : 35 - step));
                    v[s] = *(const u32x4*)(base + (size_t)slot * PLANE); dc[s] = dec[slot * 32]; }
#pragma unroll
                for (int s = 0; s < 17; ++s) { const int step = half * 17 + s; const int slot = dir == 0 ? step : (step == 0 ? 1 : (step == 1 ? 0 : 35 - step));
                    u32x4 o; o.x = cvt_pk_bf16(run[0], run[1]); o.y = cvt_pk_bf16(run[2], run[3]); o.z = cvt_pk_bf16(run[4], run[5]); o.w = cvt_pk_bf16(run[6], run[7]);
                    *(u32x4*)(base + (size_t)slot * PLANE) = o;
                    const float d = dc[s];
                    run[0] = d * run[0] + bflo(v[s].x); run[1] = d * run[1] + bfhi(v[s].x); run[2] = d * run[2] + bflo(v[s].y); run[3] = d * run[3] + bfhi(v[s].y);
                    run[4] = d * run[4] + bflo(v[s].z); run[5] = d * run[5] + bfhi(v[s].z); run[6] = d * run[6] + bflo(v[s].w); run[7] = d * run[7] + bfhi(v[s].w); }
            }
        }
    }
    SEAM(5);

    if (IN(6)) { PROBE_BEGIN(6); PHASE_VARS PHASE_PTRS
        char* Cs = lds;
        char* Bs = lds + 34816;
        char* XT = lds + 69632;
        char* Hf = lds + 87040;
        char* Hb = lds + 104448;
        float* fa = (float*)(lds + 121856);
        float* fb = (float*)(lds + 130048);
        const float* a_log = args.in[I_ALOG]; const float* d_skip = args.in[I_DSKIP];
        const int wave_u = __builtin_amdgcn_readfirstlane(wave);
        const int r = lane & 31, h = lane >> 5, tl = wave_u >> 1, tsb = (wave_u & 1) * 2;
        u32x4 px[2], phf[2], phb[2];
#define LOADXH(hd_) do { _Pragma("unroll") for (int i = 0; i < 2; ++i) { const int idx = tid + i * NTHR; \
            px[i] = *(const u32x4*)(XBC + (size_t)(row0 + (idx >> 3)) * 4096 + (hd_) * 64 + (idx & 7) * 8); \
            const size_t so = (size_t)slot * PLANE + (size_t)((hd_) * 64 + (idx >> 4)) * 128 + (idx & 15) * 8; \
            phf[i] = *(const u32x4*)(ST + (size_t)(b * 2 + 0) * NSLOT * PLANE + so); phb[i] = *(const u32x4*)(ST + (size_t)(b * 2 + 1) * NSLOT * PLANE + so); } } while (0)
#define WRITEXH() do { _Pragma("unroll") for (int i = 0; i < 2; ++i) { const int idx = tid + i * NTHR; const int l = idx >> 3, p0 = (idx & 7) * 8; const u32x4 q = px[i]; \
            const unsigned short e[8] = {(unsigned short)q.x, (unsigned short)(q.x >> 16), (unsigned short)q.y, (unsigned short)(q.y >> 16), (unsigned short)q.z, (unsigned short)(q.z >> 16), (unsigned short)q.w, (unsigned short)(q.w >> 16)}; \
            _Pragma("unroll") for (int j = 0; j < 8; ++j) *(unsigned short*)(XT + tr_off(p0 + j, l)) = e[j]; \
            *(u32x4*)(Hf + rm_off(idx >> 4, (idx & 15) * 8)) = phf[i]; *(u32x4*)(Hb + rm_off(idx >> 4, (idx & 15) * 8)) = phb[i]; } } while (0)
        for (int it = bid; it < NB * 32 * 8; it += G) {
            const int g = it & 7, c = (it >> 3) & 31, b = it >> 8, slot = c + 2; const int row0 = b * RPB + slot * 128;
            __syncthreads();
#pragma unroll
            for (int i = 0; i < 4; ++i) { const int idx = tid + i * NTHR, l = idx >> 4, n0 = (idx & 15) * 8; const bf16_t* rp = XBC + (size_t)(row0 + l) * 4096 + 2048 + g * 128 + n0;
                *(u32x4*)(Bs + rm_off(l, n0)) = *(const u32x4*)rp; *(u32x4*)(Cs + rm_off(l, n0)) = *(const u32x4*)(rp + 1024); }
#pragma unroll
            for (int i = 0; i < 2; ++i) { const int idx = tid + i * NTHR, hd = idx >> 7, l = idx & 127;
                fa[(hd >> 1) * 512 + 256 + (hd & 1) * 128 + l] = DT[(size_t)(row0 + l) * 64 + (hd & 1) * 32 + g * 4 + (hd >> 1)]; }
            LOADXH(g * 4); WRITEXH();
            __syncthreads();
            { const int hd = wave, hh = hd >> 1, dir = hd & 1; const float A = -__expf(a_log[dir * 32 + g * 4 + hh]) * 1.4426950408889634f;
              float le0, le1, tot, a0, a1; wave_scan128(fa + hh * 512 + 256 + dir * 128, lane, le0, le1, tot, a0, a1);
              const float c0 = (dir == 0 ? le0 : tot - le0 + a0) * A, c1 = (dir == 0 ? le1 : tot - le1 + a1) * A;
              *(f32x2*)(fa + hh * 512 + dir * 128 + 2 * lane) = (f32x2){c0, c1};
              *(f32x2*)(fb + hh * 256 + dir * 128 + 2 * lane) = (f32x2){c0 - __log2f(a0), c1 - __log2f(a1)}; }
            f32x16 ga[2] = {f32x16{}, f32x16{}};
#pragma unroll 2
            for (int ks = 0; ks < 8; ++ks) { const int k0 = ks * 16 + 8 * h;
                const bf16x8 cf = *(const bf16x8*)(Cs + rm_off(tl * 32 + r, k0));
#pragma unroll
                for (int t2 = 0; t2 < 2; ++t2) { const bf16x8 bf_ = *(const bf16x8*)(Bs + rm_off((tsb + t2) * 32 + r, k0)); ga[t2] = MFMA32(bf_, cf, ga[t2]); } }
            __syncthreads();
#pragma unroll 1
            for (int hh = 0; hh < 4; ++hh) {
                const int head = g * 4 + hh; const float* fh = fa + hh * 512;
                if (hh < 3) LOADXH(head + 1);
                { const int l = tl * 32 + r; const float cfl = fh[l], rcl = fh[128 + l]; const float* fbh = fb + hh * 256;
#pragma unroll
                  for (int t2 = 0; t2 < 2; ++t2) { const int ts = tsb + t2;
                    if (ts < tl) {
#pragma unroll
                        for (int q = 0; q < 4; ++q) { const int s0 = ts * 32 + 8 * q + 4 * h; const f32x4 cs = *(const f32x4*)(fbh + s0);
                            u32x2 w; w.x = cvt_pk_bf16(ga[t2][4 * q] * __builtin_amdgcn_exp2f(cfl - cs[0]), ga[t2][4 * q + 1] * __builtin_amdgcn_exp2f(cfl - cs[1]));
                            w.y = cvt_pk_bf16(ga[t2][4 * q + 2] * __builtin_amdgcn_exp2f(cfl - cs[2]), ga[t2][4 * q + 3] * __builtin_amdgcn_exp2f(cfl - cs[3]));
                            *(u32x2*)(Bs + rm_off(l, s0)) = w; }
                    } else if (ts > tl) {
#pragma unroll
                        for (int q = 0; q < 4; ++q) { const int s0 = ts * 32 + 8 * q + 4 * h; const f32x4 cs = *(const f32x4*)(fbh + 128 + s0);
                            u32x2 w; w.x = cvt_pk_bf16(ga[t2][4 * q] * __builtin_amdgcn_exp2f(rcl - cs[0]), ga[t2][4 * q + 1] * __builtin_amdgcn_exp2f(rcl - cs[1]));
                            w.y = cvt_pk_bf16(ga[t2][4 * q + 2] * __builtin_amdgcn_exp2f(rcl - cs[2]), ga[t2][4 * q + 3] * __builtin_amdgcn_exp2f(rcl - cs[3]));
                            *(u32x2*)(Bs + rm_off(l, s0)) = w; }
                    } else {
                        const float dsk = d_skip[head];
#pragma unroll
                        for (int q = 0; q < 4; ++q) { const int s0 = ts * 32 + 8 * q + 4 * h;
                            const f32x4 cfs = *(const f32x4*)(fbh + s0), rcs = *(const f32x4*)(fbh + 128 + s0);
                            float m[4];
#pragma unroll
                            for (int j = 0; j < 4; ++j) { const int s = s0 + j;
                                const float wf = s <= l ? __builtin_amdgcn_exp2f(cfl - cfs[j]) : 0.f;
                                const float wb = s >= l ? __builtin_amdgcn_exp2f(rcl - rcs[j]) : 0.f;
                                m[j] = ga[t2][4 * q + j] * (wf + wb) + (s == l ? dsk : 0.f); }
                            u32x2 w; w.x = cvt_pk_bf16(m[0], m[1]); w.y = cvt_pk_bf16(m[2], m[3]);
                            *(u32x2*)(Bs + rm_off(l, s0)) = w; }
                    } } }
                __syncthreads();
                {
                    const int tp = wave & 1;
                    float zr[16];
                    { const bf16_t* zp = P + (size_t)row0 * LDP + C_Z + head * 64 + tp * 32 + r;
#pragma unroll
                      for (int i = 0; i < 16; ++i) zr[i] = bf2f(zp[(size_t)(tl * 32 + att::crow(i, h)) * LDP]); }
                    f32x16 aD = f32x16{}, aF = f32x16{}, aB = f32x16{};
#pragma unroll 2
                    for (int ks = 0; ks < 8; ++ks) { const int k0 = ks * 16 + 8 * h;
                        const bf16x8 mf = *(const bf16x8*)(Bs + rm_off(tl * 32 + r, k0)), xf = *(const bf16x8*)(XT + tr_off(tp * 32 + r, k0));
                        const bf16x8 cf = *(const bf16x8*)(Cs + rm_off(tl * 32 + r, k0)), hf = *(const bf16x8*)(Hf + rm_off(tp * 32 + r, k0)), hb = *(const bf16x8*)(Hb + rm_off(tp * 32 + r, k0));
                        aD = MFMA32(mf, xf, aD); aF = MFMA32(cf, hf, aF); aB = MFMA32(cf, hb, aB); }
                    bf16_t* yp = P + (size_t)row0 * LDP + C_XBC + head * 64 + tp * 32 + r;
#pragma unroll
                    for (int i = 0; i < 16; ++i) { const int l = tl * 32 + att::crow(i, h);
                        const float y = aD[i] + __builtin_amdgcn_exp2f(fh[l]) * aF[i] + __builtin_amdgcn_exp2f(fh[128 + l]) * aB[i];
                        yp[(size_t)l * LDP] = f2bf(y * siluf_(zr[i])); }
                }
                __syncthreads();
                if (hh < 3) WRITEXH();
            }
            asm volatile("s_waitcnt vmcnt(0)" ::: "memory"); __syncthreads();
            { const int l = tid >> 2, qd = tid & 3; const bf16_t* src = P + (size_t)(row0 + l) * LDP + C_XBC + g * 256 + qd * 64;
              u32x4 gv[8]; float ssq = 0.f;
#pragma unroll
              for (int k = 0; k < 8; ++k) gv[k] = *(const u32x4*)(src + k * 8);
#pragma unroll
              for (int k = 0; k < 8; ++k) { const float a0 = bflo(gv[k].x), a1 = bfhi(gv[k].x), a2 = bflo(gv[k].y), a3 = bfhi(gv[k].y), a4 = bflo(gv[k].z), a5 = bfhi(gv[k].z), a6 = bflo(gv[k].w), a7 = bfhi(gv[k].w);
                  ssq += a0 * a0 + a1 * a1 + a2 * a2 + a3 * a3 + a4 * a4 + a5 * a5 + a6 * a6 + a7 * a7; }
              ssq += __shfl_xor(ssq, 1); ssq += __shfl_xor(ssq, 2);
              const float rstd = rsqrtf(ssq * (1.f / 256.f) + EPS);
              const float* nwp = args.in[I_SSMN] + g * 256 + qd * 64; bf16_t* dst = P + (size_t)(row0 + l) * LDP + C_Z + g * 256 + qd * 64;
#pragma unroll
              for (int k = 0; k < 8; ++k) { const f32x4 w0 = *(const f32x4*)(nwp + k * 8), w1 = *(const f32x4*)(nwp + k * 8 + 4);
                  u32x4 o; o.x = cvt_pk_bf16(bflo(gv[k].x) * rstd * w0[0], bfhi(gv[k].x) * rstd * w0[1]); o.y = cvt_pk_bf16(bflo(gv[k].y) * rstd * w0[2], bfhi(gv[k].y) * rstd * w0[3]);
                  o.z = cvt_pk_bf16(bflo(gv[k].z) * rstd * w1[0], bfhi(gv[k].z) * rstd * w1[1]); o.w = cvt_pk_bf16(bflo(gv[k].w) * rstd * w1[2], bfhi(gv[k].w) * rstd * w1[3]);
                  *(u32x4*)(dst + k * 8) = o; } }
        }
#undef LOADXH
#undef WRITEXH
    }
    PROBE_END(6);
    if (IN(6) && IN(13)) { PROBE_BEGIN(13); PHASE_VARS PHASE_PTRS
        for (int u = bid; u < 512; u += G) {
            const int b = u >> 8, w = u & 255, xcd = w & 7, j = w >> 3, kvh = xcd >> 1, idx = (xcd & 1) * 32 + j, rep = idx >> 4, qb = idx & 15, head = kvh * 4 + rep;
            bf16_t* Qb = P + (size_t)(b * RPB + CTXL + qb * 256) * LDP + C_Q + head * 128;
            const bf16_t* Kh = P + (size_t)(b * RPB) * LDP + C_K + kvh * 128; const bf16_t* Vh = P + (size_t)(b * RPB) * LDP + C_V + kvh * 128;
            att::attn_dense_body(Qb, Kh, Vh, Qb, RPB, lds, tid, args.in[I_QN], qb * 256);
            __syncthreads();
        }
    }
    PROBE_END(13);
    do { if (IN(6) && IN(7)) xcd_barrier(xbar, wave_s == 0 && __builtin_amdgcn_mbcnt_hi(~0u, __builtin_amdgcn_mbcnt_lo(~0u, 0u)) == 0u); } while (0);

    if (IN(7)) { PROBE_BEGIN(7); PHASE_VARS PHASE_PTRS
        __syncthreads();
        char* scr = lds + wave * 8448;
        transpose_matrix(args.in[I_WF1], DM, 2 * DFF, (bf16_t*)(ws + WS_WF1), 2 * DFF, [](int db) { const int pn = db >> 2, q = db & 3; return q < 2 ? pn * 128 + q * 64 : DFF + pn * 128 + (q - 2) * 64; }, scr, gw, ngw, lane);
        __syncthreads();
    }
    SEAM(7);

    if (IN(8)) { PROBE_BEGIN(8); PHASE_VARS PHASE_PTRS
        pg8::Sched S; S.init(32, 8, G, bid, 3);
        pg8::Gemm g{P + C_Z, (const bf16_t*)(ws + WS_WSSM), LDP, DM, DM, (size_t)(C_Q - C_Z) * 2};
        pg8::EpiMerge E{P};
        pg8::gemm_phase<pg8::EpiMerge>((LAS unsigned char*)lds_raw, g, S, E, tid);
    }
    SEAM(8);

    if (IN(9)) { PROBE_BEGIN(9); PHASE_VARS PHASE_PTRS
        pg8::Sched S; S.init(32, 8, G, bid, 1);
        pg8::Gemm g{P + C_G, (const bf16_t*)(ws + WS_WO), LDP, DM, DM};
        pg8::EpiResid<0> E{x, args.out, MOD, b_mod, 2 * DM};
        pg8::gemm_phase<pg8::EpiResid<0>>((LAS unsigned char*)lds_raw, g, S, E, tid);
    }
    SEAM(9);

    if (IN(10)) { PROBE_BEGIN(10); PHASE_VARS PHASE_PTRS
        bf16_t* XN2 = (bf16_t*)(ws + WS_XN2); const float* norm2 = args.in[I_NORM2];
        float* pl = (float*)lds;
        const int rpb = (ML + G - 1) / G;
        for (int r0 = bid * rpb; r0 < ML; r0 += G * rpb) {
            const int b = r0 >> 12;
            __syncthreads();
            for (int i = tid; i < DM; i += NTHR) { const float* mv = MOD + (size_t)b * NMOD;
                pl[i] = norm2[i] * (mv[4 * DM + i] + b_mod[4 * DM + i] + 1.f); pl[2048 + i] = mv[3 * DM + i] + b_mod[3 * DM + i]; }
            __syncthreads();
            const int rend = (r0 + rpb < ML) ? r0 + rpb : ML;
            for (int r = r0 + wave; r < rend; r += NWAVES) {
                const int rb = r >> 12; const float* src = args.out + (size_t)r * DM;
                f32x4 xv[8]; float ss = 0.f;
#pragma unroll
                for (int j = 0; j < 8; ++j) xv[j] = *(const f32x4*)(src + j * 256 + lane * 4);
#pragma unroll
                for (int j = 0; j < 8; ++j) ss += xv[j][0] * xv[j][0] + xv[j][1] * xv[j][1] + xv[j][2] * xv[j][2] + xv[j][3] * xv[j][3];
                const float rstd = rsqrtf(wave_sum(ss) * (1.f / DM) + EPS);
                if (rb == b) {
#pragma unroll
                    for (int j = 0; j < 8; ++j) { const int col = j * 256 + lane * 4;
                        const f32x4 o = xv[j] * rstd * *(const f32x4*)(pl + col) + *(const f32x4*)(pl + 2048 + col);
                        u32x2 w; w.x = cvt_pk_bf16(o[0], o[1]); w.y = cvt_pk_bf16(o[2], o[3]);
                        *(u32x2*)(XN2 + (size_t)r * DM + col) = w; }
                } else {
                    const float* mv = MOD + (size_t)rb * NMOD;
#pragma unroll
                    for (int j = 0; j < 8; ++j) { const int col = j * 256 + lane * 4;
                        const f32x4 nw = *(const f32x4*)(norm2 + col), sh = *(const f32x4*)(mv + 3 * DM + col) + *(const f32x4*)(b_mod + 3 * DM + col), sc = *(const f32x4*)(mv + 4 * DM + col) + *(const f32x4*)(b_mod + 4 * DM + col);
                        const f32x4 o = xv[j] * rstd * nw * (sc + 1.f) + sh;
                        u32x2 w; w.x = cvt_pk_bf16(o[0], o[1]); w.y = cvt_pk_bf16(o[2], o[3]);
                        *(u32x2*)(XN2 + (size_t)r * DM + col) = w; }
                }
            }
        }
    }
    SEAM(10);

    if (IN(11)) { PROBE_BEGIN(11); PHASE_VARS PHASE_PTRS
        pg8::Sched S; S.init(32, 44, G, bid, 0);
        pg8::Gemm g{(const bf16_t*)(ws + WS_XN2), (const bf16_t*)(ws + WS_WF1), DM, DM, DM};
        pg8::EpiSwiglu E{(bf16_t*)(ws + WS_HID)};
        pg8::gemm_phase<pg8::EpiSwiglu>((LAS unsigned char*)lds_raw, g, S, E, tid);
        {
            const int rounds = (S.total + G - 1) / G, last_cnt = S.total - (rounds - 1) * G, n_idle = G - last_cnt;
            const bool idle = n_idle > 0 ? (bid >= last_cnt) : true;
            if (idle) {
                const int gwi = n_idle > 0 ? (bid - last_cnt) * NWAVES + wave : gw, ngwi = n_idle > 0 ? n_idle * NWAVES : ngw;
                char* scr = lds + wave * 8448;
                transpose_matrix(args.in[I_WF2], DFF, DM, (bf16_t*)(ws + WS_WF2), DM, [](int db) { return db * 64; }, scr, gwi, ngwi, lane);
            }
        }
    }
    SEAM(11);

    if (IN(12)) { PROBE_BEGIN(12); PHASE_VARS PHASE_PTRS
        pg8::Sched S; S.init(32, 8, G, bid, 0);
        pg8::Gemm g{(const bf16_t*)(ws + WS_HID), (const bf16_t*)(ws + WS_WF2), DFF, DFF, DFF};
        pg8::EpiResid<1> E{args.out, args.out, MOD, b_mod, 5 * DM};
        pg8::gemm_phase<pg8::EpiResid<1>>((LAS unsigned char*)lds_raw, g, S, E, tid);
    }
    if (PROBE_MASK != 0 && bid == 0 && threadIdx.x == 0) { const unsigned t0 = (unsigned)__builtin_amdgcn_s_memrealtime(), wait = misc[3] * (unsigned)PROBE_MULT;
        while ((unsigned)__builtin_amdgcn_s_memrealtime() - t0 < wait) __builtin_amdgcn_s_sleep(8); }
#undef IN
#undef SEAM
}

constexpr int N_PHASES = 13;
#ifndef MK_PER_PHASE
#define MK_PER_PHASE 0
#endif
extern "C" void kernel_launch(void* const* d_in, const int* in_sizes, int n_in, void* d_out, int out_size, void* d_ws, size_t ws_size, hipStream_t stream) {
    static int grid = 0;
    if (grid == 0) {
        if (n_in != 22 || out_size != ML * DM || ws_size < WS_END) { fprintf(stderr, "kernel_launch: bad shapes n_in %d out %d ws %zu (need %zu)\n", n_in, out_size, ws_size, (size_t)WS_END); grid = -1; return; }
        int dev = 0, cus = 0, per_cu = 0;
        if (hipGetDevice(&dev) != hipSuccess || hipDeviceGetAttribute(&cus, hipDeviceAttributeMultiprocessorCount, dev) != hipSuccess) { grid = -1; return; }
        if (hipFuncSetAttribute((const void*)fwd_megakernel, hipFuncAttributeMaxDynamicSharedMemorySize, LDS_BYTES) != hipSuccess) { fprintf(stderr, "kernel_launch: hipFuncSetAttribute failed\n"); grid = -1; return; }
        if (hipOccupancyMaxActiveBlocksPerMultiprocessor(&per_cu, (const void*)fwd_megakernel, NTHR, LDS_BYTES) != hipSuccess || per_cu < 1) { fprintf(stderr, "kernel_launch: occupancy query says %d\n", per_cu); (void)hipGetLastError(); per_cu = 1; }
        grid = cus;
    }
    if (grid < 0) return;
    (void)hipMemsetAsync((char*)d_ws, 0, ZERO_BYTES, stream);
    Args a{};
    for (int i = 0; i < 22; ++i) a.in[i] = (const float*)d_in[i];
    a.out = (float*)d_out; a.ws = (unsigned char*)d_ws;
#if MK_PER_PHASE
    for (int p = 0; p < N_PHASES; ++p) { a.ph_lo = p; a.ph_hi = p + 1; hipLaunchKernelGGL(fwd_megakernel, dim3(grid), dim3(NTHR), LDS_BYTES, stream, a); }
#else
    a.ph_lo = 0; a.ph_hi = N_PHASES;
    void* kargs[] = {&a};
    hipError_t e = hipLaunchCooperativeKernel((const void*)fwd_megakernel, dim3(grid), dim3(NTHR), kargs, LDS_BYTES, stream);
    if (e != hipSuccess) fprintf(stderr, "kernel_launch: cooperative launch failed: %s (grid %d)\n", hipGetErrorString(e), grid);
#endif
}
```

```cpp
#include <hip/hip_runtime.h>
#include <hip/hip_cooperative_groups.h>
#include <cstdio>
#include <cstdint>
namespace cg = cooperative_groups;

#define DI __device__ __forceinline__
#define LAS __attribute__((address_space(3)))
typedef unsigned short bf16_t;
typedef short bf16x8 __attribute__((ext_vector_type(8)));
typedef short s16x4 __attribute__((ext_vector_type(4)));
typedef float f32x2 __attribute__((ext_vector_type(2)));
typedef float f32x4 __attribute__((ext_vector_type(4)));
typedef float f32x16 __attribute__((ext_vector_type(16)));
typedef unsigned u32x2 __attribute__((ext_vector_type(2)));
typedef unsigned u32x4 __attribute__((ext_vector_type(4)));

constexpr int DM = 2048, NB = 2, SEQ = 4096, CTXL = 256, RPB = SEQ + CTXL  , MP = NB * RPB  , ML = NB * SEQ;
constexpr int LDP = 13568;
constexpr int C_Z = 0, C_XBC = 2048, C_Q = 6144, C_K = 8192, C_V = 8704, C_G = 9216, C_DT = 13312;
constexpr int DFF = 5632, NMOD = 12288, NSLOT = 34;
constexpr float EPS = 1e-6f;
constexpr int NTHR = 512, NWAVES = 8;
constexpr int LDS_BYTES = 144 * 1024;

constexpr size_t al256(size_t x) { return (x + 255) / 256 * 256; }
constexpr size_t WS_CTL = 0;
constexpr size_t WS_MOD = 16384;
constexpr size_t ZERO_BYTES = WS_MOD + (size_t)3 * NMOD * 4;
constexpr size_t WS_DT  = al256(ZERO_BYTES);
constexpr size_t WS_DEC = al256(WS_DT + (size_t)MP * 64 * 4);
constexpr size_t WS_R1  = al256(WS_DEC + (size_t)NB * 2 * NSLOT * 32 * 4);
constexpr size_t SZ_WIN = (size_t)LDP * DM * 2;
constexpr size_t WS_WIN = WS_R1;
constexpr size_t WS_XN  = WS_R1 + SZ_WIN;
constexpr size_t SZ_R1  = SZ_WIN + (size_t)MP * DM * 2;
constexpr size_t WS_XBC = WS_R1;
constexpr size_t WS_XN2 = WS_R1;
constexpr size_t WS_R2  = al256(WS_R1 + SZ_R1);
constexpr size_t WS_WSSM = WS_R2, WS_WATT = WS_R2 + (size_t)DM * DM * 2, WS_WO = WS_R2 + (size_t)2 * DM * DM * 2;
constexpr size_t WS_R3  = al256(WS_R2 + (size_t)3 * DM * DM * 2);
constexpr size_t WS_P   = WS_R3;
constexpr size_t WS_HID = WS_R3;
constexpr size_t WS_R4  = al256(WS_R3 + (size_t)MP * LDP * 2);
constexpr size_t PLANE  = (size_t)32 * 64 * 128;
constexpr size_t WS_ST  = WS_R4;
constexpr size_t WS_WF1 = WS_R4;
constexpr size_t WS_WF2 = WS_R4 + (size_t)2 * DFF * DM * 2;
constexpr size_t WS_END = al256(WS_R4 + (size_t)NB * 2 * NSLOT * PLANE * 2);
static_assert((size_t)2 * DFF * DM * 2 + (size_t)DM * DFF * 2 <= (size_t)NB * 2 * NSLOT * PLANE * 2, "ffn weights fit the state region");
static_assert((size_t)MP * 4096 * 2 <= SZ_R1, "xbc fits r1");

DI unsigned cvt_pk_bf16(float lo, float hi) { unsigned r; asm volatile("v_cvt_pk_bf16_f32 %0, %1, %2" : "=v"(r) : "v"(lo), "v"(hi)); return r; }
DI float bflo(unsigned w) { return __uint_as_float(w << 16); }
DI float bfhi(unsigned w) { return __uint_as_float(w & 0xffff0000u); }
DI float bf2f(bf16_t b) { return __uint_as_float(((unsigned)b) << 16); }
DI bf16_t f2bf(float x) { return (bf16_t)(cvt_pk_bf16(x, 0.f) & 0xffffu); }
DI void st16_wt(void* p, u32x4 v) { asm volatile("global_store_dwordx4 %0, %1, off sc1\n\ts_nop 1" :: "v"(p), "v"(v) : "memory"); }
DI void st16f_wt(void* p, f32x4 v) { asm volatile("global_store_dwordx4 %0, %1, off sc1\n\ts_nop 1" :: "v"(p), "v"(v) : "memory"); }
DI void st8_wt(void* p, u32x2 v) { asm volatile("global_store_dwordx2 %0, %1, off sc1\n\ts_nop 1" :: "v"(p), "v"(v) : "memory"); }
DI float wave_sum(float v) { for (int o = 32; o >= 1; o >>= 1) v += __shfl_xor(v, o); return v; }
DI void wave_scan128(const float* a, int lane, float& le0, float& le1, float& tot, float& a0, float& a1) {
    const f32x2 v = *(const f32x2*)(a + 2 * lane); a0 = v.x; a1 = v.y; float inc = a0 + a1;
#pragma unroll
    for (int o = 1; o < 64; o <<= 1) { const float t = __shfl_up(inc, o); inc += lane >= o ? t : 0.f; }
    le0 = inc - a1; le1 = inc; tot = __shfl(inc, 63);
}
DI float sigmoidf_(float x) { return __builtin_amdgcn_rcpf(1.f + __builtin_amdgcn_exp2f(-1.4426950408889634f * x)); }
DI float siluf_(float x) { return x * __builtin_amdgcn_rcpf(1.f + __builtin_amdgcn_exp2f(-1.4426950408889634f * x)); }
DI float softplusf_(float x) { return fmaxf(x, 0.f) + log1pf(__expf(-fabsf(x))); }

namespace pg8 {
constexpr int BM = 256, BK = 64, HALF = 128, HTB = HALF * BK * 2, STAGE_BYTES = 8 * HTB, NXCD = 8, WGM = 8;
DI int lds_byte(int r, int c) { const int st = (r >> 4) * 2 + (c >> 5), rr = r & 15, cc = c & 31, ob = rr * 64 + cc * 2; return st * 1024 + (ob ^ (((ob >> 9) & 1) << 5)); }
DI void stage_rc(int b, int& R, int& C) { const int st = b / 1024, sb = b % 1024, swz = sb ^ (((sb >> 9) & 1) << 5); R = (st >> 1) * 16 + swz / 64; C = (st & 1) * 32 + (swz % 64) / 2; }
DI int perm32(int rho) { const int n = rho >> 4, i = rho & 15; return 8 * (i >> 2) + 4 * n + (i & 3); }
struct Unit { int pm, pn; };
struct Gemm { const bf16_t* A; const bf16_t* Bt; int lda, ldb, K; size_t a_alt; };
struct Sched {
    int nM, nN, nwg, G, c, mode, total;
    DI void init(int nM_, int nN_, int G_, int c_, int mode_) { nM = nM_; nN = nN_; nwg = nM * nN; G = G_; c = c_; mode = mode_; total = nwg + (mode == 2 ? 42 : 0); }
    DI bool next(int i, Unit& u) const {
        int which = 0; if (mode == 3) { which = i & 1; i >>= 1; }
        const int L = i * G + c; if (L >= total) return false;
        if (L >= nwg) { const int j = L - nwg, t = j / 21, q = j % 21; u.pm = t * 17; u.pn = q < 16 ? 8 + q : (q < 20 ? 32 + (q - 16) : 52); return true; }
        int wgid = L; { const int q = nwg / NXCD, r = nwg % NXCD, xcd = wgid % NXCD, off = wgid / NXCD; wgid = (xcd < r ? xcd * (q + 1) : r * (q + 1) + (xcd - r) * q) + off; }
        const int nig = WGM * nN, gid = wgid / nig, fm = gid * WGM, gsz = (nM - fm) < WGM ? (nM - fm) : WGM;
        int pm = fm + ((wgid % nig) % gsz); const int pn = (wgid % nig) / gsz;
        if (mode) pm = pm + 1 + (pm >= 16 ? 1 : 0);
        u.pm = pm; u.pn = pn + 8 * which; return true;
    }
};

template <class Epi>
DI void gemm_phase(LAS unsigned char* lds, const Gemm g, const Sched& S, const Epi& E, int tid) {
    asm volatile("" : "+v"(tid));
    const int wid = __builtin_amdgcn_readfirstlane(tid >> 6), lane = tid & 63, wr = wid >> 2, wc = wid & 3, fr = lane & 15, fq = lane >> 4;
    const int K = g.K, nt = K / BK;
    unsigned voffA[2], voffB[2];
#pragma unroll
    for (int i = 0; i < 2; ++i) { int R, C; stage_rc(tid * 16 + i * 8192, R, C); const int Rb = Epi::PERM ? ((R & ~31) + perm32(R & 31)) : R;
        voffA[i] = (unsigned)(R * g.lda + C) * 2u; voffB[i] = (unsigned)(Rb * g.ldb + C) * 2u; }
    const size_t kstep = (size_t)(BK * 2);
    const size_t hstepA = (size_t)HALF * g.lda * 2, hstepB = (size_t)HALF * g.ldb * 2;
    const size_t tstepA = 2 * hstepA, tstepB = 2 * hstepB;
    const unsigned ldsw = (unsigned)wid * 1024u;
    const int aoff = lds_byte(wr * 64 + fr, fq * 8), boff = lds_byte(wc * 32 + fr, fq * 8);
#define PG8_SA(b, h) (((b) * 2 + (h)) * HTB)
#define PG8_SB(b, h) ((4 + (b) * 2 + (h)) * HTB)
#define PG8_STAGE(bufoff, gbase, voff) do { _Pragma("unroll") for (int _i = 0; _i < 2; ++_i) \
        __builtin_amdgcn_global_load_lds((const unsigned*)((const char*)(gbase) + (voff)[_i]), (LAS unsigned*)(lds + (bufoff) + ldsw + _i * 8192), 16, 0, 0); } while (0)
#define PG8_LDA(dst, b, h) do { _Pragma("unroll") for (int m = 0; m < 4; ++m) _Pragma("unroll") for (int k = 0; k < 2; ++k) dst[m][k] = *(const LAS bf16x8*)(lds + PG8_SA(b, h) + aoff + m * 2048 + k * 1024); } while (0)
#define PG8_LDB(dst, b, h) do { _Pragma("unroll") for (int n = 0; n < 2; ++n) _Pragma("unroll") for (int k = 0; k < 2; ++k) dst[n][k] = *(const LAS bf16x8*)(lds + PG8_SB(b, h) + boff + n * 2048 + k * 1024); } while (0)
#define PG8_MMA(ai, bj, At, Bt) do { __builtin_amdgcn_s_setprio(1); _Pragma("unroll") for (int m = 0; m < 4; ++m) _Pragma("unroll") for (int n = 0; n < 2; ++n) _Pragma("unroll") for (int k = 0; k < 2; ++k) \
        acc[ai][bj][m][n] = __builtin_amdgcn_mfma_f32_16x16x32_bf16(Bt[n][k], At[m][k], acc[ai][bj][m][n], 0, 0, 0); __builtin_amdgcn_s_setprio(0); } while (0)
#define PG8_WAIT_V(n) asm volatile("s_waitcnt vmcnt(" #n ")" ::: "memory")
#define PG8_WAIT_L(n) asm volatile("s_waitcnt lgkmcnt(" #n ")" ::: "memory")
#define PG8_BAR __builtin_amdgcn_s_barrier()
#define PG8_SCHED __builtin_amdgcn_sched_barrier(0)
    Unit cur, nxt; int ui = 0;
    if (!S.next(0, cur)) return;
    f32x4 acc[2][2][4][2];
#pragma unroll
    for (int a = 0; a < 2; ++a)
#pragma unroll
        for (int b = 0; b < 2; ++b)
#pragma unroll
            for (int m = 0; m < 4; ++m)
#pragma unroll
                for (int n = 0; n < 2; ++n) acc[a][b][m][n] = (f32x4){0.f, 0.f, 0.f, 0.f};
    bf16x8 At[4][2], B0[2][2], B1[2][2];
    const char* cA = (const char*)g.A + (size_t)cur.pm * tstepA + (cur.pn >= 8 ? g.a_alt : (size_t)0); const char* cB = (const char*)g.Bt + (size_t)cur.pn * tstepB;
    PG8_STAGE(PG8_SB(0, 0), cB, voffB); PG8_STAGE(PG8_SA(0, 0), cA, voffA); PG8_STAGE(PG8_SB(0, 1), cB + hstepB, voffB); PG8_STAGE(PG8_SA(0, 1), cA + hstepA, voffA);
    if (wr == 1) PG8_BAR;
    PG8_WAIT_V(4); PG8_BAR;
    PG8_STAGE(PG8_SB(1, 0), cB + kstep, voffB); PG8_STAGE(PG8_SA(1, 0), cA + kstep, voffA); PG8_STAGE(PG8_SB(1, 1), cB + hstepB + kstep, voffB);
    PG8_WAIT_V(6); PG8_BAR;
    for (;;) {
        const bool has_next = S.next(ui + 1, nxt);
        const char* nA = has_next ? (const char*)g.A + (size_t)nxt.pm * tstepA + (nxt.pn >= 8 ? g.a_alt : (size_t)0) : cA; const char* nB = has_next ? (const char*)g.Bt + (size_t)nxt.pn * tstepB : cB;
        for (int t = 0; t < nt; t += 2) {
            const bool last = (t == nt - 2);
            const char* a1 = cA + (size_t)(t + 1) * kstep;
            const char* a2 = last ? nA : cA + (size_t)(t + 2) * kstep; const char* b2 = last ? nB : cB + (size_t)(t + 2) * kstep;
            const char* a3 = a2 + kstep; const char* b3 = b2 + kstep;
            PG8_LDB(B0, 0, 0); PG8_SCHED; PG8_LDA(At, 0, 0); PG8_STAGE(PG8_SA(1, 1), a1 + hstepA, voffA);
            PG8_WAIT_L(8); PG8_BAR; PG8_WAIT_L(0); PG8_MMA(0, 0, At, B0); PG8_BAR; PG8_SCHED;
            PG8_LDB(B1, 0, 1); PG8_STAGE(PG8_SB(0, 0), b2, voffB);
            PG8_BAR; PG8_WAIT_L(0); PG8_MMA(0, 1, At, B1); PG8_BAR;
            PG8_LDA(At, 0, 1); PG8_STAGE(PG8_SA(0, 0), a2, voffA);
            PG8_BAR; PG8_WAIT_L(0); PG8_MMA(1, 0, At, B0); PG8_BAR; PG8_SCHED;
            PG8_STAGE(PG8_SB(0, 1), b2 + hstepB, voffB);
            PG8_WAIT_V(6); PG8_BAR; PG8_MMA(1, 1, At, B1); PG8_BAR;
            PG8_LDB(B0, 1, 0); PG8_SCHED; PG8_LDA(At, 1, 0); PG8_STAGE(PG8_SA(0, 1), a2 + hstepA, voffA);
            PG8_WAIT_L(8); PG8_BAR; PG8_WAIT_L(0); PG8_MMA(0, 0, At, B0); PG8_BAR; PG8_SCHED;
            PG8_LDB(B1, 1, 1); PG8_STAGE(PG8_SB(1, 0), b3, voffB);
            PG8_BAR; PG8_WAIT_L(0); PG8_MMA(0, 1, At, B1); PG8_BAR;
            PG8_LDA(At, 1, 1); PG8_STAGE(PG8_SA(1, 0), a3, voffA);
            PG8_BAR; PG8_WAIT_L(0); PG8_MMA(1, 0, At, B0); PG8_BAR; PG8_SCHED;
            PG8_STAGE(PG8_SB(1, 1), b3 + hstepB, voffB);
            PG8_WAIT_V(6); PG8_BAR; PG8_MMA(1, 1, At, B1); PG8_BAR;
        }
        bool keep_acc = false;
        if constexpr (Epi::CHAIN) { if (cur.pn < 8) { E.mid(acc, cur, wr, wc, fr, fq); keep_acc = true; } else E(acc, cur, wr, wc, fr, fq); }
        else E(acc, cur, wr, wc, fr, fq);
        if (!has_next) break;
        if (!keep_acc)
#pragma unroll
        for (int a = 0; a < 2; ++a)
#pragma unroll
            for (int b = 0; b < 2; ++b)
#pragma unroll
                for (int m = 0; m < 4; ++m)
#pragma unroll
                    for (int n = 0; n < 2; ++n) acc[a][b][m][n] = (f32x4){0.f, 0.f, 0.f, 0.f};
        cur = nxt; cA = nA; cB = nB; ++ui;
    }
    PG8_WAIT_V(0);
    if (wr == 0) PG8_BAR;
    PG8_BAR;
#undef PG8_SA
#undef PG8_SB
#undef PG8_STAGE
#undef PG8_LDA
#undef PG8_LDB
#undef PG8_MMA
#undef PG8_WAIT_V
#undef PG8_WAIT_L
#undef PG8_BAR
#undef PG8_SCHED
}

struct EpiInProj {
    static constexpr bool PERM = true, CHAIN = false;
    bf16_t* P; float* DT; const float* dt_bias;
    DI void operator()(const f32x4 (&acc)[2][2][4][2], const Unit& u, int wr, int wc, int fr, int fq) const {
        const int row0 = u.pm * BM + wr * 64 + fr;
        if (u.pn < 52) {
            const int col0 = u.pn * BM + wc * 32 + 8 * fq;
#pragma unroll
            for (int ai = 0; ai < 2; ++ai)
#pragma unroll
                for (int m = 0; m < 4; ++m) { bf16_t* rowp = P + (size_t)(row0 + ai * HALF + m * 16) * LDP + col0;
#pragma unroll
                    for (int bj = 0; bj < 2; ++bj) { const f32x4 v0 = acc[ai][bj][m][0], v1 = acc[ai][bj][m][1];
                        u32x4 w; w.x = cvt_pk_bf16(v0[0], v0[1]); w.y = cvt_pk_bf16(v0[2], v0[3]); w.z = cvt_pk_bf16(v1[0], v1[1]); w.w = cvt_pk_bf16(v1[2], v1[3]);
                        *(u32x4*)(rowp + bj * HALF) = w; } }
        } else if (wc < 2) {
            const int c0 = wc * 32 + 8 * fq;
#pragma unroll
            for (int ai = 0; ai < 2; ++ai)
#pragma unroll
                for (int m = 0; m < 4; ++m) { float* rowp = DT + (size_t)(row0 + ai * HALF + m * 16) * 64 + c0;
#pragma unroll
                    for (int n = 0; n < 2; ++n) { f32x4 v = acc[ai][0][m][n];
#pragma unroll
                        for (int j = 0; j < 4; ++j) v[j] = softplusf_(v[j] + dt_bias[c0 + 4 * n + j]);
                        *(f32x4*)(rowp + 4 * n) = v; } }
        }
    }
};
template <int SECOND> struct EpiBranch {
    static constexpr bool PERM = true, CHAIN = false;
    bf16_t* P;
    DI void operator()(const f32x4 (&acc)[2][2][4][2], const Unit& u, int wr, int wc, int fr, int fq) const {
        const int row0 = u.pm * BM + wr * 64 + fr, col0 = C_G + u.pn * BM + wc * 32 + 8 * fq;
#pragma unroll
        for (int aim = 0; aim < 4; ++aim) { const int ai = aim >> 1, m0 = (aim & 1) * 2;
            u32x4 gwv[4][2], pwv[4][2];
#pragma unroll
            for (int m = m0; m < m0 + 2; ++m) { const bf16_t* rowp = P + (size_t)(row0 + ai * HALF + m * 16) * LDP + col0;
#pragma unroll
                for (int bj = 0; bj < 2; ++bj) { gwv[m][bj] = *(const u32x4*)(rowp + bj * HALF + (SECOND ? DM : 0)); if (SECOND) pwv[m][bj] = *(const u32x4*)(rowp + bj * HALF); } }
#pragma unroll
            for (int m = m0; m < m0 + 2; ++m) { bf16_t* rowp = P + (size_t)(row0 + ai * HALF + m * 16) * LDP + col0;
#pragma unroll
                for (int bj = 0; bj < 2; ++bj) { const f32x4 v0 = acc[ai][bj][m][0], v1 = acc[ai][bj][m][1];
                    const u32x4 gw = gwv[m][bj];
                    float r[8];
                    r[0] = sigmoidf_(bflo(gw.x)) * v0[0]; r[1] = sigmoidf_(bfhi(gw.x)) * v0[1]; r[2] = sigmoidf_(bflo(gw.y)) * v0[2]; r[3] = sigmoidf_(bfhi(gw.y)) * v0[3];
                    r[4] = sigmoidf_(bflo(gw.z)) * v1[0]; r[5] = sigmoidf_(bfhi(gw.z)) * v1[1]; r[6] = sigmoidf_(bflo(gw.w)) * v1[2]; r[7] = sigmoidf_(bfhi(gw.w)) * v1[3];
                    if (SECOND) { const u32x4 pw = pwv[m][bj];
                        r[0] += bflo(pw.x); r[1] += bfhi(pw.x); r[2] += bflo(pw.y); r[3] += bfhi(pw.y); r[4] += bflo(pw.z); r[5] += bfhi(pw.z); r[6] += bflo(pw.w); r[7] += bfhi(pw.w); }
                    u32x4 w; w.x = cvt_pk_bf16(r[0], r[1]); w.y = cvt_pk_bf16(r[2], r[3]); w.z = cvt_pk_bf16(r[4], r[5]); w.w = cvt_pk_bf16(r[6], r[7]);
                    *(u32x4*)(rowp + bj * HALF) = w; } }
            asm volatile("" ::: "memory");
        }
    }
};
template <int INP> struct EpiResid {
    static constexpr bool PERM = false, CHAIN = false;
    const float* base; float* out; const float* mod; const float* b_mod; int goff;
    DI void operator()(const f32x4 (&acc)[2][2][4][2], const Unit& u, int wr, int wc, int fr, int fq) const {
        const int b = INP ? (u.pm >= 16 ? 1 : 0) : (u.pm >= 17 ? 1 : 0);
        const int lat0 = (INP ? u.pm * BM : u.pm * BM - 256 * (b + 1)) + wr * 64 + fr, col0 = u.pn * BM + wc * 32 + 4 * fq;
        f32x4 gv[2][2];
#pragma unroll
        for (int bj = 0; bj < 2; ++bj)
#pragma unroll
            for (int n = 0; n < 2; ++n) gv[bj][n] = *(const f32x4*)(mod + (size_t)b * NMOD + goff + col0 + bj * HALF + n * 16) + *(const f32x4*)(b_mod + goff + col0 + bj * HALF + n * 16);
#pragma unroll
        for (int aim = 0; aim < 4; ++aim) { const int ai = aim >> 1, m0 = (aim & 1) * 2;
            f32x4 bsv[4][2][2];
#pragma unroll
            for (int m = m0; m < m0 + 2; ++m) { const size_t off = (size_t)(lat0 + ai * HALF + m * 16) * DM + col0;
#pragma unroll
                for (int bj = 0; bj < 2; ++bj)
#pragma unroll
                    for (int n = 0; n < 2; ++n) bsv[m][bj][n] = *(const f32x4*)(base + off + bj * HALF + n * 16); }
#pragma unroll
            for (int m = m0; m < m0 + 2; ++m) { const size_t off = (size_t)(lat0 + ai * HALF + m * 16) * DM + col0;
#pragma unroll
                for (int bj = 0; bj < 2; ++bj)
#pragma unroll
                    for (int n = 0; n < 2; ++n) *(f32x4*)(out + off + bj * HALF + n * 16) = bsv[m][bj][n] + gv[bj][n] * acc[ai][bj][m][n]; }
            asm volatile("" ::: "memory");
        }
    }
};
struct EpiMerge {
    static constexpr bool PERM = true, CHAIN = true;
    bf16_t* P;
    static DI float eneg(float g) { return __builtin_amdgcn_exp2f(fminf(-1.4426950408889634f * g, 64.f)); }
    DI void mid(f32x4 (&acc)[2][2][4][2], const Unit& u, int wr, int wc, int fr, int fq) const {
        const int row0 = u.pm * BM + wr * 64 + fr, col0 = C_G + u.pn * BM + wc * 32 + 8 * fq;
#pragma unroll
        for (int aim = 0; aim < 4; ++aim) { const int ai = aim >> 1, m0 = (aim & 1) * 2;
            u32x4 g1v[4][2], g2v[4][2];
#pragma unroll
            for (int m = m0; m < m0 + 2; ++m) { const bf16_t* rowp = P + (size_t)(row0 + ai * HALF + m * 16) * LDP + col0;
#pragma unroll
                for (int bj = 0; bj < 2; ++bj) { g1v[m][bj] = *(const u32x4*)(rowp + bj * HALF); g2v[m][bj] = *(const u32x4*)(rowp + bj * HALF + DM); } }
#pragma unroll
            for (int m = m0; m < m0 + 2; ++m)
#pragma unroll
                for (int bj = 0; bj < 2; ++bj) { const u32x4 a = g1v[m][bj], c = g2v[m][bj];
                    const float g1[8] = {bflo(a.x), bfhi(a.x), bflo(a.y), bfhi(a.y), bflo(a.z), bfhi(a.z), bflo(a.w), bfhi(a.w)};
                    const float g2[8] = {bflo(c.x), bfhi(c.x), bflo(c.y), bfhi(c.y), bflo(c.z), bfhi(c.z), bflo(c.w), bfhi(c.w)};
#pragma unroll
                    for (int j = 0; j < 8; ++j) { const float ratio = (1.f + eneg(g2[j])) * __builtin_amdgcn_rcpf(1.f + eneg(g1[j])); acc[ai][bj][m][j >> 2][j & 3] *= ratio; } }
            asm volatile("" ::: "memory");
        }
    }
    DI void operator()(const f32x4 (&acc)[2][2][4][2], const Unit& u, int wr, int wc, int fr, int fq) const {
        const int row0 = u.pm * BM + wr * 64 + fr, col0 = C_G + (u.pn - 8) * BM + wc * 32 + 8 * fq;
#pragma unroll
        for (int aim = 0; aim < 4; ++aim) { const int ai = aim >> 1, m0 = (aim & 1) * 2;
            u32x4 g2v[4][2];
#pragma unroll
            for (int m = m0; m < m0 + 2; ++m) { const bf16_t* rowp = P + (size_t)(row0 + ai * HALF + m * 16) * LDP + col0;
#pragma unroll
                for (int bj = 0; bj < 2; ++bj) g2v[m][bj] = *(const u32x4*)(rowp + bj * HALF + DM); }
#pragma unroll
            for (int m = m0; m < m0 + 2; ++m) { bf16_t* rowp = P + (size_t)(row0 + ai * HALF + m * 16) * LDP + col0;
#pragma unroll
                for (int bj = 0; bj < 2; ++bj) { const u32x4 c = g2v[m][bj]; const f32x4 v0 = acc[ai][bj][m][0], v1 = acc[ai][bj][m][1];
                    const float g2[8] = {bflo(c.x), bfhi(c.x), bflo(c.y), bfhi(c.y), bflo(c.z), bfhi(c.z), bflo(c.w), bfhi(c.w)};
                    float r[8];
#pragma unroll
                    for (int j = 0; j < 8; ++j) r[j] = (j < 4 ? v0[j & 3] : v1[j & 3]) * __builtin_amdgcn_rcpf(1.f + eneg(g2[j]));
                    u32x4 w; w.x = cvt_pk_bf16(r[0], r[1]); w.y = cvt_pk_bf16(r[2], r[3]); w.z = cvt_pk_bf16(r[4], r[5]); w.w = cvt_pk_bf16(r[6], r[7]);
                    *(u32x4*)(rowp + bj * HALF) = w; } }
            asm volatile("" ::: "memory");
        }
    }
};
struct EpiSwiglu {
    static constexpr bool PERM = true, CHAIN = false;
    bf16_t* H;
    DI void operator()(const f32x4 (&acc)[2][2][4][2], const Unit& u, int wr, int wc, int fr, int fq) const {
        const int row0 = u.pm * BM + wr * 64 + fr, col0 = u.pn * HALF + wc * 32 + 8 * fq;
#pragma unroll
        for (int ai = 0; ai < 2; ++ai)
#pragma unroll
            for (int m = 0; m < 4; ++m) { bf16_t* rowp = H + (size_t)(row0 + ai * HALF + m * 16) * DFF + col0;
                const f32x4 g0 = acc[ai][0][m][0], g1 = acc[ai][0][m][1], u0 = acc[ai][1][m][0], u1 = acc[ai][1][m][1];
                u32x4 w; w.x = cvt_pk_bf16(siluf_(g0[0]) * u0[0], siluf_(g0[1]) * u0[1]); w.y = cvt_pk_bf16(siluf_(g0[2]) * u0[2], siluf_(g0[3]) * u0[3]);
                w.z = cvt_pk_bf16(siluf_(g1[0]) * u1[0], siluf_(g1[1]) * u1[1]); w.w = cvt_pk_bf16(siluf_(g1[2]) * u1[2], siluf_(g1[3]) * u1[3]);
                *(u32x4*)rowp = w; asm volatile("" ::: "memory"); }
    }
};
}

namespace att {
constexpr int D = 128, NW = 8, QBLK = 32, KVBLK = 64;
constexpr float SCALE = 0.088388347648318440f;
constexpr float THR = 8.f;
constexpr int LDQ = LDP, LDK = LDP, LDO = LDP;
constexpr size_t SHM_V = KVBLK * D * 2, SHM_K = KVBLK * D * 2, SHM_ATTN = 2 * SHM_V + 2 * SHM_K + NW * 64 * 4;
#define KSWZ(row, colB) ((row) * 256 + ((colB) ^ (((row) & 7) << 4)))
#define SBAR() __builtin_amdgcn_sched_barrier(0)
DI int crow(int r, int hi) { return (r & 3) + 8 * (r >> 2) + 4 * hi; }
DI unsigned cvtpk(float lo, float hi) { unsigned r; asm volatile("v_cvt_pk_bf16_f32 %0, %1, %2" : "=v"(r) : "v"(lo), "v"(hi)); return r; }
DI bf16x8 ld8(const bf16_t* p) { return *reinterpret_cast<const bf16x8*>(p); }
DI void partialSM(f32x16& p0, f32x16& p1, float& m_reg, float& mn, float& alpha) {
  constexpr float C = SCALE * 1.4426950408889634f;
  float pmax = p0[0]; for (int r = 1; r < 16; ++r) pmax = fmaxf(pmax, p0[r]); for (int r = 0; r < 16; ++r) pmax = fmaxf(pmax, p1[r]);
  { auto rr = __builtin_amdgcn_permlane32_swap(__float_as_uint(pmax), __float_as_uint(pmax), false, false);
    pmax = fmaxf(__uint_as_float(rr[0]), __uint_as_float(rr[1])); }
  if (__builtin_expect(__all(pmax - m_reg <= THR / SCALE), 1)) { mn = m_reg; alpha = 1.f; }
  else { mn = fmaxf(m_reg, pmax); alpha = __builtin_amdgcn_exp2f((m_reg - mn) * C); m_reg = mn; }
  float mnC = -mn * C;
  for (int r = 0; r < 16; ++r) p0[r] = fmaf(p0[r], C, mnC); for (int r = 0; r < 16; ++r) p1[r] = fmaf(p1[r], C, mnC);
  for (int r = 0; r < 16; ++r) p0[r] = __builtin_amdgcn_exp2f(p0[r]);
}
DI void finishSM(f32x16& p0, f32x16& p1, float alpha, float& l_reg, bf16x8& pa0, bf16x8& pa1, bf16x8& pa2, bf16x8& pa3) {
  for (int r = 0; r < 16; ++r) p1[r] = __builtin_amdgcn_exp2f(p1[r]);
  float ps = 0; for (int r = 0; r < 16; ++r) ps += p0[r]; for (int r = 0; r < 16; ++r) ps += p1[r];
  { auto rr = __builtin_amdgcn_permlane32_swap(__float_as_uint(ps), __float_as_uint(ps), false, false);
    ps = __uint_as_float(rr[0]) + __uint_as_float(rr[1]); }
  l_reg = l_reg * alpha + ps;
#define PK4(P, BASE, OUT) do { unsigned a0 = cvtpk(P[BASE + 0], P[BASE + 1]), a1 = cvtpk(P[BASE + 2], P[BASE + 3]);   \
    unsigned b0 = cvtpk(P[BASE + 4], P[BASE + 5]), b1 = cvtpk(P[BASE + 6], P[BASE + 7]);                              \
    auto r0 = __builtin_amdgcn_permlane32_swap(a0, b0, false, false); auto r1 = __builtin_amdgcn_permlane32_swap(a1, b1, false, false); \
    u32x4 w = {r0[0], r1[0], r0[1], r1[1]}; OUT = *reinterpret_cast<bf16x8*>(&w); } while (0)
  PK4(p0, 0, pa0); PK4(p0, 8, pa1); PK4(p1, 0, pa2); PK4(p1, 8, pa3);
#undef PK4
}
DI void qkt(f32x16& p0, f32x16& p1, const bf16_t* Ks, const bf16x8* qr, int r32, int hi) {
  p0 = f32x16{}; p1 = f32x16{};
  for (int d0 = 0; d0 < 8; ++d0) { int cb = (d0 * 16 + hi * 8) * 2;
    bf16x8 b0 = *reinterpret_cast<const bf16x8*>((const char*)Ks + KSWZ(r32, cb));
    bf16x8 b1 = *reinterpret_cast<const bf16x8*>((const char*)Ks + KSWZ(32 + r32, cb));
    p0 = __builtin_amdgcn_mfma_f32_32x32x16_bf16(b0, qr[d0], p0, 0, 0, 0);
    p1 = __builtin_amdgcn_mfma_f32_32x32x16_bf16(b1, qr[d0], p1, 0, 0, 0); }
}
DI int v_st(int k, int c) { const int kk = (k & ~0xC) | ((k & 4) << 1) | ((k & 8) >> 1); return ((kk >> 3) * 4 + (c >> 5)) * 512 + ((kk & 7) * 32 + (c & 31)) * 2; }
DI int v_rd_base(int lane) { return ((lane & 3) << 3) | (((lane >> 2) & 3) << 6) | (((lane >> 4) & 1) << 5) | (((lane >> 5) & 1) << 8); }
constexpr int v_rd_off(int d0, int ks, int half) { return d0 * 512 + ks * 4096 + half * 2048; }
template <int OFF> DI s16x4 tr_read(int vb) {
  s16x4 r; asm volatile("ds_read_b64_tr_b16 %0, %1 offset:%2" : "=&v"(r) : "v"(vb), "i"(OFF) : "memory"); return r;
}
template <int D0> DI void pv_one(f32x16& od, int vb, bf16x8 pa0, bf16x8 pa1, bf16x8 pa2, bf16x8 pa3) {
  const s16x4 l0 = tr_read<v_rd_off(D0, 0, 0)>(vb), h0 = tr_read<v_rd_off(D0, 0, 1)>(vb), l1 = tr_read<v_rd_off(D0, 1, 0)>(vb), h1 = tr_read<v_rd_off(D0, 1, 1)>(vb);
  const s16x4 l2 = tr_read<v_rd_off(D0, 2, 0)>(vb), h2 = tr_read<v_rd_off(D0, 2, 1)>(vb), l3 = tr_read<v_rd_off(D0, 3, 0)>(vb), h3 = tr_read<v_rd_off(D0, 3, 1)>(vb);
  asm volatile("s_waitcnt lgkmcnt(0)" ::: "memory"); SBAR();
#define PK(L, H) (bf16x8){L[0], L[1], L[2], L[3], H[0], H[1], H[2], H[3]}
  od = __builtin_amdgcn_mfma_f32_32x32x16_bf16(pa0, PK(l0, h0), od, 0, 0, 0);
  od = __builtin_amdgcn_mfma_f32_32x32x16_bf16(pa1, PK(l1, h1), od, 0, 0, 0);
  od = __builtin_amdgcn_mfma_f32_32x32x16_bf16(pa2, PK(l2, h2), od, 0, 0, 0);
  od = __builtin_amdgcn_mfma_f32_32x32x16_bf16(pa3, PK(l3, h3), od, 0, 0, 0);
#undef PK
}
DI void pv_d0(f32x16* o, int vb, bf16x8 pa0, bf16x8 pa1, bf16x8 pa2, bf16x8 pa3) {
  pv_one<0>(o[0], vb, pa0, pa1, pa2, pa3); pv_one<1>(o[1], vb, pa0, pa1, pa2, pa3); pv_one<2>(o[2], vb, pa0, pa1, pa2, pa3); pv_one<3>(o[3], vb, pa0, pa1, pa2, pa3);
}
DI void attn_dense_body(const bf16_t* __restrict__ Qb, const bf16_t* __restrict__ Kh, const bf16_t* __restrict__ Vh, bf16_t* Ob, int seq, char* lds, int tid, const float* __restrict__ qnw, int t0) {
  asm volatile("" : "+v"(tid));
  const int wid = tid >> 6, lane = tid & 63, r32 = lane & 31, hi = lane >> 5;
  bf16_t* V_lds = (bf16_t*)lds; bf16_t* K_lds = (bf16_t*)(lds + 2 * SHM_V);
  float* ws = (float*)(lds + 2 * SHM_V + 2 * SHM_K) + wid * 64; float* li_l = ws; float* al_l = ws + 32;
  float m_reg = -1e30f, l_reg = 0; f32x16 o[4] = {}; bf16x8 qr[8];
  const bf16_t* Qw = Qb + (long)(wid * QBLK + r32) * LDQ + hi * 8;
  {
    float qf[8][8]; float ssq = 0.f;
#pragma unroll
    for (int d0 = 0; d0 < 8; ++d0) { const u32x4 w = *reinterpret_cast<const u32x4*>(Qw + d0 * 16);
      qf[d0][0] = bflo(w.x); qf[d0][1] = bfhi(w.x); qf[d0][2] = bflo(w.y); qf[d0][3] = bfhi(w.y); qf[d0][4] = bflo(w.z); qf[d0][5] = bfhi(w.z); qf[d0][6] = bflo(w.w); qf[d0][7] = bfhi(w.w); }
#pragma unroll
    for (int d0 = 0; d0 < 8; ++d0)
#pragma unroll
      for (int j = 0; j < 8; ++j) ssq += qf[d0][j] * qf[d0][j];
    { auto rr = __builtin_amdgcn_permlane32_swap(__float_as_uint(ssq), __float_as_uint(ssq), false, false); ssq = __uint_as_float(rr[0]) + __uint_as_float(rr[1]); }
    const float rstd = rsqrtf(ssq * (1.f / 128.f) + EPS);
    const int tok = t0 + wid * QBLK + r32; const float posr = (float)(tok >> 6), posc = (float)(tok & 63);
#pragma unroll
    for (int d0 = 0; d0 < 8; ++d0) { const f32x4 wa = *reinterpret_cast<const f32x4*>(qnw + d0 * 16 + hi * 8), wb = *reinterpret_cast<const f32x4*>(qnw + d0 * 16 + hi * 8 + 4);
      qf[d0][0] *= rstd * wa[0]; qf[d0][1] *= rstd * wa[1]; qf[d0][2] *= rstd * wa[2]; qf[d0][3] *= rstd * wa[3]; qf[d0][4] *= rstd * wb[0]; qf[d0][5] *= rstd * wb[1]; qf[d0][6] *= rstd * wb[2]; qf[d0][7] *= rstd * wb[3]; }
#pragma unroll
    for (int q = 0; q < 4; ++q) { const int da = (q >> 1) * 4 + (q & 1), db = da + 2; const float pos = (q >> 1) ? posc : posr;
#pragma unroll
      for (int j = 0; j < 8; ++j) { const int f = (da & 1) * 16 + hi * 8 + j;
        float rev = pos * (exp2f(-(float)f * (13.287712379549449f / 32.f)) * 0.15915494309189535f); rev = rev - floorf(rev);
        const float cs = __builtin_amdgcn_cosf(rev), sn = __builtin_amdgcn_sinf(rev), n1 = qf[da][j], n2 = qf[db][j];
        qf[da][j] = n1 * cs - n2 * sn; qf[db][j] = n2 * cs + n1 * sn; } }
#pragma unroll
    for (int d0 = 0; d0 < 8; ++d0) { u32x4 w = {cvtpk(qf[d0][0], qf[d0][1]), cvtpk(qf[d0][2], qf[d0][3]), cvtpk(qf[d0][4], qf[d0][5]), cvtpk(qf[d0][6], qf[d0][7])}; qr[d0] = *reinterpret_cast<bf16x8*>(&w); }
  }
  const int sr = tid >> 4, sc = (tid & 15) * 8, vst0 = v_st(sr, sc), vst1 = v_st(32 + sr, sc);
  const int vb0 = (int)(uintptr_t)V_lds + v_rd_base(lane);
  constexpr int SDEPTH = 1;
  struct { bf16x8 vs0, vs1, ks0, ks1; } sr_[SDEPTH];
#define SLOAD(i, k0) do { sr_[i].vs0 = ld8(&Vh[(long)((k0) + sr) * LDK + sc]); sr_[i].vs1 = ld8(&Vh[(long)((k0) + 32 + sr) * LDK + sc]); \
    sr_[i].ks0 = ld8(&Kh[(long)((k0) + sr) * LDK + sc]); sr_[i].ks1 = ld8(&Kh[(long)((k0) + 32 + sr) * LDK + sc]); } while (0)
#define SWRITE(b, i) do { *(bf16x8*)((char*)V_lds + (b) * SHM_V + vst0) = sr_[i].vs0;          \
    *(bf16x8*)((char*)V_lds + (b) * SHM_V + vst1) = sr_[i].vs1; int kc = sc * 2;               \
    *(bf16x8*)((char*)K_lds + (b) * SHM_K + KSWZ(sr, kc)) = sr_[i].ks0;                       \
    *(bf16x8*)((char*)K_lds + (b) * SHM_K + KSWZ(32 + sr, kc)) = sr_[i].ks1; } while (0)
#define SWAIT() do { if constexpr (SDEPTH == 2) asm volatile("s_waitcnt vmcnt(4)" ::: "memory"); else asm volatile("s_waitcnt vmcnt(0)" ::: "memory"); } while (0)
#define RESC(a) do { if (__any((a) < 1.f)) { if (hi == 0) al_l[r32] = (a); asm volatile("s_waitcnt lgkmcnt(0)" ::: "memory"); \
    for (int d = 0; d < 4; ++d) for (int r = 0; r < 16; ++r) o[d][r] *= al_l[crow(r, hi)]; } } while (0)
  f32x16 pA0, pA1, pB0, pB1; float mnA, mnB, alA, alB; bf16x8 pa0, pa1, pa2, pa3; const int NT = seq / KVBLK;
  constexpr int SE = 0, SO = SDEPTH - 1;
  SLOAD(SE, 0); asm volatile("s_waitcnt vmcnt(0)" ::: "memory"); SWRITE(0, SE); __syncthreads();
  qkt(pA0, pA1, K_lds, qr, r32, hi); partialSM(pA0, pA1, m_reg, mnA, alA);
  SLOAD(SO, KVBLK); if constexpr (SDEPTH == 2) { if (2 < NT) SLOAD(SE, 2 * KVBLK); }
  SWAIT(); SWRITE(1, SO); __syncthreads();
  for (int j = 1; j + 1 < NT; j += 2) {
    SBAR(); qkt(pB0, pB1, (bf16_t*)((char*)K_lds + SHM_K), qr, r32, hi);
    finishSM(pA0, pA1, alA, l_reg, pa0, pa1, pa2, pa3); SBAR();
    SLOAD(SO, (j + SDEPTH) * KVBLK); SBAR();
    pv_d0(o, vb0, pa0, pa1, pa2, pa3); partialSM(pB0, pB1, m_reg, mnB, alB);
    __syncthreads(); SWAIT(); SWRITE(0, SE);
    RESC(alB); __syncthreads();
    SBAR(); qkt(pA0, pA1, K_lds, qr, r32, hi);
    finishSM(pB0, pB1, alB, l_reg, pa0, pa1, pa2, pa3); SBAR();
    if (SDEPTH == 1 || j + 3 < NT) SLOAD(SE, (j + 1 + SDEPTH) * KVBLK); SBAR();
    pv_d0(o, vb0 + (int)SHM_V, pa0, pa1, pa2, pa3); partialSM(pA0, pA1, m_reg, mnA, alA);
    __syncthreads(); SWAIT(); SWRITE(1, SO);
    RESC(alA); __syncthreads();
  }
  SBAR(); qkt(pB0, pB1, (bf16_t*)((char*)K_lds + SHM_K), qr, r32, hi);
  finishSM(pA0, pA1, alA, l_reg, pa0, pa1, pa2, pa3); SBAR();
  pv_d0(o, vb0, pa0, pa1, pa2, pa3); partialSM(pB0, pB1, m_reg, mnB, alB);
  __syncthreads(); RESC(alB);
  finishSM(pB0, pB1, alB, l_reg, pa0, pa1, pa2, pa3); SBAR();
  pv_d0(o, vb0 + (int)SHM_V, pa0, pa1, pa2, pa3);
  if (hi == 0) li_l[r32] = l_reg; asm volatile("s_waitcnt lgkmcnt(0)" ::: "memory");
  float rli[16];
#pragma unroll
  for (int r = 0; r < 16; ++r) rli[r] = __builtin_amdgcn_rcpf(li_l[crow(r, hi)]);
  bf16_t* Ow = Ob + (long)(wid * QBLK) * LDO;
#pragma unroll
  for (int r = 0; r < 16; ++r) { int orow = crow(r, hi);
    for (int d0 = 0; d0 < 4; ++d0) Ow[(long)orow * LDO + d0 * 32 + r32] = f2bf(o[d0][r] * rli[r]); }
#undef SLOAD
#undef SWRITE
#undef SWAIT
#undef RESC
}
}

#define XB_TMO      128
#define XB_XCNT(j)  (256  + 64 * (j))
#define XB_XSUB(j)  (1280 + 64 * (j))
#define XB_XGEN(j)  (2304 + 64 * (j))
#define XB_TOP      3328
#define XB_TOPGEN   3392
#define XCD_BAR_WORDS 3456
#define XB_SPIN_CAP (1u << 18)
DI unsigned xb_ld(unsigned* p)              { return __hip_atomic_load(p, __ATOMIC_RELAXED, __HIP_MEMORY_SCOPE_AGENT); }
DI unsigned xb_add(unsigned* p, unsigned v) { return __hip_atomic_fetch_add(p, v, __ATOMIC_RELAXED, __HIP_MEMORY_SCOPE_AGENT); }
DI unsigned xb_xcc_id() { return (unsigned)__builtin_amdgcn_s_getreg((3 << 11) | 20) & 0xFu; }
#define XB_SPIN(cond, bar) do { unsigned _sp = 0; while (cond) { __builtin_amdgcn_s_sleep(1); \
    if ((++_sp & 255u) == 0u) { if (xb_ld(&(bar)[XB_TMO])) break; if (_sp > XB_SPIN_CAP) { atomicAdd(&(bar)[XB_TMO], 1u); break; } } } } while (0)
struct XcdBarrier { unsigned* bar; unsigned x; volatile LAS unsigned* st; };
DI XcdBarrier xcd_barrier_post(unsigned* bar, volatile LAS unsigned* st) {
    XcdBarrier b; b.bar = bar; b.x = xb_xcc_id(); b.st = st;
    if (threadIdx.x == 0) (void)xb_add(&bar[XB_XCNT(b.x)], 1u);
    return b;
}
DI void xcd_barrier_complete(unsigned* bar, unsigned x, unsigned& nloc, unsigned& nx) {
    const unsigned G = gridDim.x * gridDim.y * gridDim.z;
    unsigned sum, cnt, mine, sp = 0u;
    for (;;) {
        sum = 0u; cnt = 0u; mine = 0u;
#pragma unroll
        for (unsigned j = 0; j < 16; ++j) { const unsigned c = xb_ld(&bar[XB_XCNT(j)]); sum += c; cnt += (c > 0u) ? 1u : 0u; mine = (j == x) ? c : mine; }
        if (sum == G) break;
        __builtin_amdgcn_s_sleep(1);
        if ((++sp & 255u) == 0u) { if (xb_ld(&bar[XB_TMO])) break; if (sp > XB_SPIN_CAP) { atomicAdd(&bar[XB_TMO], 1u); break; } }
    }
    nloc = mine > 0u ? mine : 1u; nx = cnt > 0u ? cnt : 1u;
}
DI void xcd_barrier(const XcdBarrier& b, bool leader) {
    asm volatile("s_waitcnt vmcnt(0)" ::: "memory");
    __syncthreads();
    if (leader) {
        unsigned* bar = b.bar;
        __builtin_amdgcn_s_waitcnt(0);
        unsigned nloc = b.st[0], nx = b.st[1];
        if (nloc == 0u) { xcd_barrier_complete(bar, b.x, nloc, nx); b.st[0] = nloc; b.st[1] = nx; }
        const unsigned old = xb_add(&bar[XB_XSUB(b.x)], 1u);
        const unsigned gen = old / nloc;
        if (old + 1u == (gen + 1u) * nloc) {
            __builtin_amdgcn_fence(__ATOMIC_RELEASE, "agent");
            asm volatile("s_waitcnt vmcnt(0)" ::: "memory");
            const unsigned og = xb_add(&bar[XB_TOP], 1u);
            const unsigned tg = og / nx;
            if (og + 1u == (tg + 1u) * nx) xb_add(&bar[XB_TOPGEN], 1u);
            else XB_SPIN(xb_ld(&bar[XB_TOPGEN]) == tg, bar);
            __builtin_amdgcn_fence(__ATOMIC_ACQUIRE, "agent");
            xb_add(&bar[XB_XGEN(b.x)], 1u);
            asm volatile("s_waitcnt vmcnt(0)" ::: "memory");
        } else {
            XB_SPIN(xb_ld(&bar[XB_XGEN(b.x)]) == gen, bar);
            __builtin_amdgcn_fence(__ATOMIC_ACQUIRE, "agent");
            asm volatile("s_waitcnt vmcnt(0)" ::: "memory");
        }
    }
    __syncthreads();
}
static_assert(XCD_BAR_WORDS * 4 <= WS_MOD, "barrier words fit the zeroed control region");

struct Args { const float* in[22]; float* out; unsigned char* ws; int ph_lo, ph_hi; };
enum { I_X = 0, I_C, I_CTX, I_CCTX, I_WMOD, I_BMOD, I_NORM1, I_WIN, I_CONVW, I_CONVB, I_DTB, I_ALOG, I_DSKIP, I_SSMN, I_QN, I_KN, I_WSSM, I_WATT, I_WO, I_NORM2, I_WF1, I_WF2 };

DI void transpose_item(const float* src, int ldw, bf16_t* dst, int ldt, char* scr, int lane) {
    if (src == nullptr) {
#pragma unroll
        for (int i = 0; i < 8; ++i) { const int n = i * 8 + (lane >> 3), k = (lane & 7) * 8; *(u32x4*)(dst + (size_t)n * ldt + k) = (u32x4){0u, 0u, 0u, 0u}; }
        return;
    }
    f32x4 v[16];
#pragma unroll
    for (int i = 0; i < 16; ++i) { const int k = i * 4 + (lane >> 4), n = (lane & 15) * 4; v[i] = *(const f32x4*)(src + (size_t)k * ldw + n); }
#pragma unroll
    for (int i = 0; i < 16; ++i) { const int k = i * 4 + (lane >> 4), n = (lane & 15) * 4;
        *(unsigned*)(scr + (k * 66 + n) * 2) = cvt_pk_bf16(v[i][0], v[i][1]); *(unsigned*)(scr + (k * 66 + n + 2) * 2) = cvt_pk_bf16(v[i][2], v[i][3]); }
    asm volatile("s_waitcnt lgkmcnt(0)" ::: "memory");
#pragma unroll
    for (int i = 0; i < 8; ++i) { const int n = i * 8 + (lane >> 3), k = (lane & 7) * 8;
        unsigned short e[8];
#pragma unroll
        for (int j = 0; j < 8; ++j) e[j] = *(const unsigned short*)(scr + ((k + j) * 66 + n) * 2);
        u32x4 w; w.x = e[0] | ((unsigned)e[1] << 16); w.y = e[2] | ((unsigned)e[3] << 16); w.z = e[4] | ((unsigned)e[5] << 16); w.w = e[6] | ((unsigned)e[7] << 16);
        st16_wt(dst + (size_t)n * ldt + k, w); }
    asm volatile("s_waitcnt lgkmcnt(0)" ::: "memory");
}
template <class F> DI void transpose_matrix(const float* W, int K, int N, bf16_t* Wt, int nd, F srccol, char* scr, int gw, int ngw, int lane) {
    const int kb = K / 64, items = (nd / 64) * kb;
    for (int it = gw; it < items; it += ngw) { const int db = it / kb, k0 = (it % kb) * 64; const int sc = srccol(db);
        transpose_item(sc < 0 ? nullptr : W + (size_t)k0 * N + sc, N, Wt + (size_t)db * 64 * K + k0, K, scr, lane); }
}

DI int rm_off(int row, int col) { return row * 272 + col * 2; }
DI int tr_off(int row, int col) { return row * 272 + ((((col >> 3) ^ (row >> 3)) & 15) << 4) + ((col & 7) << 1); }
#define MFMA32(a, b, c) __builtin_amdgcn_mfma_f32_32x32x16_bf16((a), (b), (c), 0, 0, 0)

__global__ void __launch_bounds__(NTHR, 2) fwd_megakernel(Args args) {
    extern __shared__ __attribute__((aligned(16))) unsigned char lds_raw[];
    cg::grid_group grid = cg::this_grid();
    char* lds = (char*)lds_raw;
    const int G = gridDim.x, bid = blockIdx.x, ngw = G * NWAVES;
    const int wave_s = __builtin_amdgcn_readfirstlane((int)threadIdx.x >> 6);
#define PHASE_VARS int tid = wave_s * 64 + (int)__builtin_amdgcn_mbcnt_hi(~0u, __builtin_amdgcn_mbcnt_lo(~0u, 0u)); asm volatile("" : "+v"(tid)); const int lane = tid & 63, wave = tid >> 6, gw = bid * NWAVES + wave; (void)lane; (void)wave; (void)gw; unsigned char* ws = args.ws; asm volatile("" : "+s"(ws));
    unsigned char* ws0 = args.ws;
#define PHASE_PTRS const float* x = args.in[I_X]; const float* b_mod = args.in[I_BMOD]; \
    float* MOD = (float*)(ws + WS_MOD); float* DT = (float*)(ws + WS_DT); float* DEC = (float*)(ws + WS_DEC); \
    bf16_t* P = (bf16_t*)(ws + WS_P); bf16_t* XBC = (bf16_t*)(ws + WS_XBC); bf16_t* ST = (bf16_t*)(ws + WS_ST); \
    (void)x; (void)b_mod; (void)MOD; (void)DT; (void)DEC; (void)P; (void)XBC; (void)ST; (void)ws0;
    const int lo = args.ph_lo, hi = args.ph_hi;
#ifndef PH_MASK
#define PH_MASK 0xFFFF
#endif
#define IN(k) (((PH_MASK >> (k)) & 1) && ((k) == 13 || (lo <= (k) && (k) < hi)))
#ifndef PROBE_MASK
#define PROBE_MASK 0
#endif
#ifndef PROBE_MULT
#define PROBE_MULT 4
#endif
    volatile LAS unsigned* misc = (volatile LAS unsigned*)(lds_raw + LDS_BYTES - 32);
    if (threadIdx.x == 0) { misc[0] = 0u; misc[1] = 0u; misc[2] = 0u; misc[3] = 0u; }
    __syncthreads();
    XcdBarrier xbar = xcd_barrier_post((unsigned*)(ws0 + WS_CTL), misc);
    if (lo < 0) grid.sync();
#define PROBE_BEGIN(k) do { if (((PROBE_MASK >> (k)) & 1) && bid == 0 && threadIdx.x == 0) misc[2] = (unsigned)__builtin_amdgcn_s_memrealtime(); } while (0)
#define PROBE_END(k) do { if (((PROBE_MASK >> (k)) & 1) && bid == 0 && threadIdx.x == 0) misc[3] = misc[3] + ((unsigned)__builtin_amdgcn_s_memrealtime() - misc[2]); } while (0)
#define SEAM(k) do { if (IN(k) && IN((k) + 1)) xcd_barrier(xbar, wave_s == 0 && __builtin_amdgcn_mbcnt_hi(~0u, __builtin_amdgcn_mbcnt_lo(~0u, 0u)) == 0u); PROBE_END(k); } while (0)

    if (IN(0)) { PROBE_BEGIN(0); PHASE_VARS PHASE_PTRS
        char* scr = lds + wave * 8448;
        transpose_matrix(args.in[I_WIN], DM, 13376, (bf16_t*)(ws + WS_WIN), LDP, [](int db) { const int n = db * 64; return n < 6144 ? n : (n < 13312 ? n + 64 : (n < 13376 ? n - 13312 + 6144 : -1)); }, scr, gw, ngw, lane);
        __syncthreads();
        float* sv = (float*)lds;
        for (int it = bid; it < 256; it += G) {
            const int ng = it & 7, kg = it >> 3;
            __syncthreads();
            if (tid < 192) { const int v = tid >> 6, kk = tid & 63, k = kg * 64 + kk; const float cv = v < 2 ? args.in[I_C][v * DM + k] : args.in[I_CCTX][k]; sv[tid] = siluf_(cv); }
            __syncthreads();
            if (tid < 384) {
                const int col = ng * 1536 + tid * 4; const float* wp = args.in[I_WMOD] + (size_t)(kg * 64) * NMOD + col;
                f32x4 a0 = {0.f, 0.f, 0.f, 0.f}, a1 = a0, a2 = a0;
#pragma unroll 8
                for (int kk = 0; kk < 64; ++kk) { const f32x4 w = *(const f32x4*)(wp + (size_t)kk * NMOD); a0 += w * sv[kk]; a1 += w * sv[64 + kk]; a2 += w * sv[128 + kk]; }
#pragma unroll
                for (int j = 0; j < 4; ++j) { atomicAdd(MOD + col + j, a0[j]); atomicAdd(MOD + NMOD + col + j, a1[j]); atomicAdd(MOD + 2 * NMOD + col + j, a2[j]); }
            }
        }
    }
    SEAM(0);

    if (IN(1)) { PROBE_BEGIN(1); PHASE_VARS PHASE_PTRS
        bf16_t* XN = (bf16_t*)(ws + WS_XN); const float* norm1 = args.in[I_NORM1];
        float* pl = (float*)lds;
        const int rpb = (MP + G - 1) / G;
        for (int r0 = bid * rpb; r0 < MP; r0 += G * rpb) {
            const int b = r0 / RPB;
            __syncthreads();
            for (int i = tid; i < 2 * DM; i += NTHR) { const int var = i >> 11, col = i & (DM - 1); const float* mv = MOD + (size_t)(var ? 2 : b) * NMOD;
                const float nw = norm1[col]; pl[var * 4096 + col] = nw * (mv[DM + col] + b_mod[DM + col] + 1.f); pl[var * 4096 + 2048 + col] = mv[col] + b_mod[col]; }
            __syncthreads();
            const int rend = (r0 + rpb < MP) ? r0 + rpb : MP;
            for (int r = r0 + wave; r < rend; r += NWAVES) {
                const int rb = r / RPB, t = r % RPB; const int var = t < CTXL ? 1 : 0;
                const float* src = t < CTXL ? args.in[I_CTX] + (size_t)(rb * CTXL + t) * DM : x + (size_t)(rb * SEQ + t - CTXL) * DM;
                f32x4 xv[8]; float ss = 0.f;
#pragma unroll
                for (int j = 0; j < 8; ++j) xv[j] = *(const f32x4*)(src + j * 256 + lane * 4);
#pragma unroll
                for (int j = 0; j < 8; ++j) ss += xv[j][0] * xv[j][0] + xv[j][1] * xv[j][1] + xv[j][2] * xv[j][2] + xv[j][3] * xv[j][3];
                const float rstd = rsqrtf(wave_sum(ss) * (1.f / DM) + EPS);
                if (rb == b) {
#pragma unroll
                    for (int j = 0; j < 8; ++j) { const int col = j * 256 + lane * 4;
                        const f32x4 o = xv[j] * rstd * *(const f32x4*)(pl + var * 4096 + col) + *(const f32x4*)(pl + var * 4096 + 2048 + col);
                        u32x2 w; w.x = cvt_pk_bf16(o[0], o[1]); w.y = cvt_pk_bf16(o[2], o[3]);
                        st8_wt(XN + (size_t)r * DM + col, w); }
                } else {
                    const float* mv = MOD + (size_t)(var ? 2 : rb) * NMOD;
#pragma unroll
                    for (int j = 0; j < 8; ++j) { const int col = j * 256 + lane * 4;
                        const f32x4 nw = *(const f32x4*)(norm1 + col), sh = *(const f32x4*)(mv + col) + *(const f32x4*)(b_mod + col), sc = *(const f32x4*)(mv + DM + col) + *(const f32x4*)(b_mod + DM + col);
                        const f32x4 o = xv[j] * rstd * nw * (sc + 1.f) + sh;
                        u32x2 w; w.x = cvt_pk_bf16(o[0], o[1]); w.y = cvt_pk_bf16(o[2], o[3]);
                        st8_wt(XN + (size_t)r * DM + col, w); }
                }
            }
        }
    }
    SEAM(1);

    if (IN(2)) { PROBE_BEGIN(2); PHASE_VARS PHASE_PTRS
        pg8::Gemm g{(const bf16_t*)(ws + WS_XN), (const bf16_t*)(ws + WS_WIN), DM, DM, DM};
        pg8::Sched S; S.init(32, 53, G, bid, 2);
        pg8::EpiInProj E{P, DT, args.in[I_DTB]};
        pg8::gemm_phase<pg8::EpiInProj>((LAS unsigned char*)lds_raw, g, S, E, tid);
        {
            const int rounds = (S.total + G - 1) / G, last_cnt = S.total - (rounds - 1) * G, n_idle = G - last_cnt;
            const bool idle = n_idle > 0 ? (bid >= last_cnt) : true;
            if (idle) {
                const int gwi = n_idle > 0 ? (bid - last_cnt) * NWAVES + wave : gw, ngwi = n_idle > 0 ? n_idle * NWAVES : ngw;
                char* scr = lds + wave * 8448;
                transpose_matrix(args.in[I_WSSM], DM, DM, (bf16_t*)(ws + WS_WSSM), DM, [](int db) { return db * 64; }, scr, gwi, ngwi, lane);
                transpose_matrix(args.in[I_WATT], DM, DM, (bf16_t*)(ws + WS_WATT), DM, [](int db) { return db * 64; }, scr, gwi, ngwi, lane);
                transpose_matrix(args.in[I_WO], DM, DM, (bf16_t*)(ws + WS_WO), DM, [](int db) { return db * 64; }, scr, gwi, ngwi, lane);
            }
        }
    }
    SEAM(2);

    if (IN(3)) { PROBE_BEGIN(3); PHASE_VARS PHASE_PTRS
        const float* cw = args.in[I_CONVW]; const float* cb = args.in[I_CONVB];
        const int gt = bid * NTHR + tid, ngt = G * NTHR;
        float w[5][8], bias[8];
        { const int ch = (gt & 511) * 8;
#pragma unroll
            for (int j = 0; j < 5; ++j) { const f32x4 a = *(const f32x4*)(cw + j * 4096 + ch), c2 = *(const f32x4*)(cw + j * 4096 + ch + 4);
                w[j][0] = a[0]; w[j][1] = a[1]; w[j][2] = a[2]; w[j][3] = a[3]; w[j][4] = c2[0]; w[j][5] = c2[1]; w[j][6] = c2[2]; w[j][7] = c2[3]; }
            { const f32x4 a = *(const f32x4*)(cb + ch), c2 = *(const f32x4*)(cb + ch + 4); bias[0] = a[0]; bias[1] = a[1]; bias[2] = a[2]; bias[3] = a[3]; bias[4] = c2[0]; bias[5] = c2[1]; bias[6] = c2[2]; bias[7] = c2[3]; } }
        for (int it = gt; it < 512 * 512; it += ngt) {
            const int cg8 = it & 511, rb = it >> 9, ch = cg8 * 8, r0 = rb * 17;
            const bf16_t* src = P + C_XBC + ch;
            u32x4 rw[21];
#pragma unroll
            for (int k = 0; k < 21; ++k) { const int rr = r0 - 2 + k; rw[k] = (rr >= 0 && rr < MP) ? *(const u32x4*)(src + (size_t)rr * LDP) : (u32x4){0u, 0u, 0u, 0u}; }
#pragma unroll
            for (int i = 0; i < 17; ++i) {
                const int ro = r0 + i; const int so = (ro / RPB) * 2 + ((ro % RPB) >= CTXL ? 1 : 0);
                float o[8];
#pragma unroll
                for (int e = 0; e < 8; ++e) o[e] = bias[e];
#pragma unroll
                for (int j = 0; j < 5; ++j) { const int rt = ro + j - 2; const int rtc = rt < 0 ? 0 : rt;
                    const bool ok = rt >= 0 && rt < MP && ((rtc / RPB) * 2 + ((rtc % RPB) >= CTXL ? 1 : 0)) == so;
                    if (ok) { const u32x4 q = rw[i + j];
                        o[0] += w[j][0] * bflo(q.x); o[1] += w[j][1] * bfhi(q.x); o[2] += w[j][2] * bflo(q.y); o[3] += w[j][3] * bfhi(q.y);
                        o[4] += w[j][4] * bflo(q.z); o[5] += w[j][5] * bfhi(q.z); o[6] += w[j][6] * bflo(q.w); o[7] += w[j][7] * bfhi(q.w); } }
                u32x4 ov; ov.x = cvt_pk_bf16(siluf_(o[0]), siluf_(o[1])); ov.y = cvt_pk_bf16(siluf_(o[2]), siluf_(o[3])); ov.z = cvt_pk_bf16(siluf_(o[4]), siluf_(o[5])); ov.w = cvt_pk_bf16(siluf_(o[6]), siluf_(o[7]));
                st16_wt(XBC + (size_t)ro * 4096 + ch, ov);
            }
        }
        const int sec = lane >> 5, f = lane & 31, e0 = sec * 64 + f, e1 = e0 + 32;
        const float qn0 = args.in[I_QN][e0], qn1 = args.in[I_QN][e1], kn0 = args.in[I_KN][e0], kn1 = args.in[I_KN][e1];
        const float inv_rev = exp2f(-(float)f * (13.287712379549449f / 32.f)) * 0.15915494309189535f;
        for (int r = gw; r < MP; r += ngw) {
            const int t = r % RPB; const bool lat = t >= CTXL; const int tl = t - CTXL;
            float cs = 1.f, sn = 0.f;
            if (lat) { const float pos = (float)(sec == 0 ? (tl >> 6) : (tl & 63)); float rev = pos * inv_rev; rev = rev - floorf(rev); cs = __builtin_amdgcn_cosf(rev); sn = __builtin_amdgcn_sinf(rev); }
            bf16_t* rowp = P + (size_t)r * LDP;
            if (lat) {
                float v0[4], v1[4], ss[4];
#pragma unroll
                for (int k = 0; k < 4; ++k) { const bf16_t* hp = rowp + C_K + k * 128; v0[k] = bf2f(hp[e0]); v1[k] = bf2f(hp[e1]); ss[k] = v0[k] * v0[k] + v1[k] * v1[k]; }
#pragma unroll
                for (int o = 32; o >= 1; o >>= 1) {
#pragma unroll
                    for (int k = 0; k < 4; ++k) ss[k] += __shfl_xor(ss[k], o); }
#pragma unroll
                for (int k = 0; k < 4; ++k) { bf16_t* hp = rowp + C_K + k * 128;
                    const float rstd = rsqrtf(ss[k] * (1.f / 128.f) + EPS);
                    const float n0 = v0[k] * rstd * kn0, n1 = v1[k] * rstd * kn1;
                    hp[e0] = f2bf(n0 * cs - n1 * sn); hp[e1] = f2bf(n1 * cs + n0 * sn); }
            } else {
                float v0[4], v1[4], ss[4];
#pragma unroll
                for (int k = 0; k < 4; ++k) { const bf16_t* hp = rowp + C_K + k * 128; v0[k] = bf2f(hp[e0]); v1[k] = bf2f(hp[e1]); ss[k] = v0[k] * v0[k] + v1[k] * v1[k]; }
#pragma unroll
                for (int k = 0; k < 4; ++k) ss[k] = wave_sum(ss[k]);
#pragma unroll
                for (int k = 0; k < 4; ++k) { bf16_t* hp = rowp + C_K + k * 128; const float rstd = rsqrtf(ss[k] * (1.f / 128.f) + EPS);
                    hp[e0] = f2bf(v0[k] * rstd * kn0); hp[e1] = f2bf(v1[k] * rstd * kn1); }
            }
        }
    }
    SEAM(3);

    if (IN(4)) { PROBE_BEGIN(4); PHASE_VARS PHASE_PTRS
        char* BT = lds;
        char* XT = lds + 34816;
        float* dtv = (float*)(lds + 104448);
        float* wv = dtv + 1024;
        const float* a_log = args.in[I_ALOG];
        for (int it = bid; it < NB * NSLOT * 8; it += G) {
            const int g = it & 7, slot = (it >> 3) % NSLOT, b = it / (8 * NSLOT); const int row0 = b * RPB + slot * 128;
            __syncthreads();
#pragma unroll
            for (int i = 0; i < 4; ++i) { const int idx = tid + i * NTHR, l = idx >> 4, n0 = (idx & 15) * 8;
                const u32x4 q = *(const u32x4*)(XBC + (size_t)(row0 + l) * 4096 + 2048 + g * 128 + n0);
                const unsigned short e[8] = {(unsigned short)q.x, (unsigned short)(q.x >> 16), (unsigned short)q.y, (unsigned short)(q.y >> 16), (unsigned short)q.z, (unsigned short)(q.z >> 16), (unsigned short)q.w, (unsigned short)(q.w >> 16)};
#pragma unroll
                for (int j = 0; j < 8; ++j) *(unsigned short*)(BT + tr_off(n0 + j, l)) = e[j]; }
#pragma unroll
            for (int i = 0; i < 8; ++i) { const int idx = tid + i * NTHR, l = idx >> 5, p0 = (idx & 31) * 8;
                const u32x4 q = *(const u32x4*)(XBC + (size_t)(row0 + l) * 4096 + g * 256 + p0);
                const unsigned short e[8] = {(unsigned short)q.x, (unsigned short)(q.x >> 16), (unsigned short)q.y, (unsigned short)(q.y >> 16), (unsigned short)q.z, (unsigned short)(q.z >> 16), (unsigned short)q.w, (unsigned short)(q.w >> 16)};
#pragma unroll
                for (int j = 0; j < 8; ++j) *(unsigned short*)(XT + tr_off(p0 + j, l)) = e[j]; }
#pragma unroll
            for (int i = 0; i < 2; ++i) { const int idx = tid + i * NTHR, hd = idx >> 7, l = idx & 127, dir = hd >> 2, hh = hd & 3;
                dtv[idx] = DT[(size_t)(row0 + l) * 64 + dir * 32 + g * 4 + hh]; }
            __syncthreads();
            { const int hd = wave, dir = hd >> 2, hh = hd & 3; const float A = -__expf(a_log[dir * 32 + g * 4 + hh]);
              float le0, le1, tot, a0, a1; wave_scan128(dtv + hd * 128, lane, le0, le1, tot, a0, a1);
              const float e0 = dir == 0 ? tot - le0 : le0 - a0, e1 = dir == 0 ? tot - le1 : le1 - a1;
              *(f32x2*)(wv + hd * 128 + 2 * lane) = (f32x2){__expf(e0 * A) * a0, __expf(e1 * A) * a1};
              if (lane == 0) DEC[((size_t)(b * 2 + dir) * NSLOT + slot) * 32 + g * 4 + hh] = __expf(tot * A); }
            __syncthreads();
            const int hh = wave >> 1, dir = wave & 1, hd = dir * 4 + hh, r = lane & 31, h = lane >> 5;
            f32x16 acc[2][4];
#pragma unroll
            for (int a = 0; a < 2; ++a)
#pragma unroll
                for (int c = 0; c < 4; ++c) acc[a][c] = f32x16{};
#pragma unroll 2
            for (int ks = 0; ks < 8; ++ks) {
                const int k0 = ks * 16 + 8 * h;
                const f32x4 w0 = *(const f32x4*)(wv + hd * 128 + k0), w1 = *(const f32x4*)(wv + hd * 128 + k0 + 4);
                bf16x8 xf[2], bfr[4];
#pragma unroll
                for (int tp = 0; tp < 2; ++tp) { const u32x4 q = *(const u32x4*)(XT + tr_off(hh * 64 + tp * 32 + r, k0));
                    u32x4 o; o.x = cvt_pk_bf16(bflo(q.x) * w0[0], bfhi(q.x) * w0[1]); o.y = cvt_pk_bf16(bflo(q.y) * w0[2], bfhi(q.y) * w0[3]);
                    o.z = cvt_pk_bf16(bflo(q.z) * w1[0], bfhi(q.z) * w1[1]); o.w = cvt_pk_bf16(bflo(q.w) * w1[2], bfhi(q.w) * w1[3]);
                    xf[tp] = __builtin_bit_cast(bf16x8, o); }
#pragma unroll
                for (int tn = 0; tn < 4; ++tn) bfr[tn] = *(const bf16x8*)(BT + tr_off(tn * 32 + r, k0));
#pragma unroll
                for (int tp = 0; tp < 2; ++tp)
#pragma unroll
                    for (int tn = 0; tn < 4; ++tn) acc[tp][tn] = MFMA32(bfr[tn], xf[tp], acc[tp][tn]);
            }
            bf16_t* sp = ST + ((size_t)(b * 2 + dir) * NSLOT + slot) * PLANE + (size_t)(g * 4 + hh) * 64 * 128;
#pragma unroll
            for (int tp = 0; tp < 2; ++tp)
#pragma unroll
                for (int tn = 0; tn < 4; ++tn)
#pragma unroll
                    for (int q = 0; q < 4; ++q) { const f32x16& a = acc[tp][tn];
                        u32x2 w; w.x = cvt_pk_bf16(a[4 * q], a[4 * q + 1]); w.y = cvt_pk_bf16(a[4 * q + 2], a[4 * q + 3]);
                        *(u32x2*)(sp + (size_t)(tp * 32 + r) * 128 + tn * 32 + 8 * q + 4 * h) = w; }
        }
    }
    SEAM(4);

    if (IN(5)) { PROBE_BEGIN(5); PHASE_VARS PHASE_PTRS
        const int gt = bid * NTHR + tid, ngt = G * NTHR;
        for (int it = gt; it < NB * 2 * 32 * 64 * 16; it += ngt) {
            const int e = (it & 32767) * 8, head = (it >> 10) & 31, bd = it >> 15, dir = bd & 1;
            bf16_t* base = ST + (size_t)bd * NSLOT * PLANE + e; const float* dec = DEC + (size_t)bd * NSLOT * 32 + head;
            float run[8] = {0.f, 0.f, 0.f, 0.f, 0.f, 0.f, 0.f, 0.f};
#pragma unroll
            for (int half = 0; half < 2; ++half) {
                u32x4 v[17]; float dc[17];
#pragma unroll
                for (int s = 0; s < 17; ++s) { const int step = half * 17 + s; const int slot = dir == 0 ? step : (step == 0 ? 1 : (step == 1 ? 0 : 35 - step));
                    v[s] = *(const u32x4*)(base + (size_t)slot * PLANE); dc[s] = dec[slot * 32]; }
#pragma unroll
                for (int s = 0; s < 17; ++s) { const int step = half * 17 + s; const int slot = dir == 0 ? step : (step == 0 ? 1 : (step == 1 ? 0 : 35 - step));
                    u32x4 o; o.x = cvt_pk_bf16(run[0], run[1]); o.y = cvt_pk_bf16(run[2], run[3]); o.z = cvt_pk_bf16(run[4], run[5]); o.w = cvt_pk_bf16(run[6], run[7]);
                    st16_wt(base + (size_t)slot * PLANE, o);
                    const float d = dc[s];
                    run[0] = d * run[0] + bflo(v[s].x); run[1] = d * run[1] + bfhi(v[s].x); run[2] = d * run[2] + bflo(v[s].y); run[3] = d * run[3] + bfhi(v[s].y);
                    run[4] = d * run[4] + bflo(v[s].z); run[5] = d * run[5] + bfhi(v[s].z); run[6] = d * run[6] + bflo(v[s].w); run[7] = d * run[7] + bfhi(v[s].w); }
            }
        }
    }
    SEAM(5);

    if (IN(6)) { PROBE_BEGIN(6); PHASE_VARS PHASE_PTRS
        char* Cs = lds;
        char* Bs = lds + 34816;
        char* XT = lds + 69632;
        char* Hf = lds + 87040;
        char* Hb = lds + 104448;
        float* fa = (float*)(lds + 121856);
        float* fb = (float*)(lds + 130048);
        const float* a_log = args.in[I_ALOG]; const float* d_skip = args.in[I_DSKIP];
        const int wave_u = __builtin_amdgcn_readfirstlane(wave);
        const int r = lane & 31, h = lane >> 5, tl = wave_u >> 1, tsb = (wave_u & 1) * 2;
        u32x4 px[2], phf[2], phb[2];
#define LOADXH(hd_) do { _Pragma("unroll") for (int i = 0; i < 2; ++i) { const int idx = tid + i * NTHR; \
            px[i] = *(const u32x4*)(XBC + (size_t)(row0 + (idx >> 3)) * 4096 + (hd_) * 64 + (idx & 7) * 8); \
            const size_t so = (size_t)slot * PLANE + (size_t)((hd_) * 64 + (idx >> 4)) * 128 + (idx & 15) * 8; \
            phf[i] = *(const u32x4*)(ST + (size_t)(b * 2 + 0) * NSLOT * PLANE + so); phb[i] = *(const u32x4*)(ST + (size_t)(b * 2 + 1) * NSLOT * PLANE + so); } } while (0)
#define WRITEXH() do { _Pragma("unroll") for (int i = 0; i < 2; ++i) { const int idx = tid + i * NTHR; const int l = idx >> 3, p0 = (idx & 7) * 8; const u32x4 q = px[i]; \
            const unsigned short e[8] = {(unsigned short)q.x, (unsigned short)(q.x >> 16), (unsigned short)q.y, (unsigned short)(q.y >> 16), (unsigned short)q.z, (unsigned short)(q.z >> 16), (unsigned short)q.w, (unsigned short)(q.w >> 16)}; \
            _Pragma("unroll") for (int j = 0; j < 8; ++j) *(unsigned short*)(XT + tr_off(p0 + j, l)) = e[j]; \
            *(u32x4*)(Hf + rm_off(idx >> 4, (idx & 15) * 8)) = phf[i]; *(u32x4*)(Hb + rm_off(idx >> 4, (idx & 15) * 8)) = phb[i]; } } while (0)
        for (int it = bid; it < NB * 32 * 8; it += G) {
            const int g = it & 7, c = (it >> 3) & 31, b = it >> 8, slot = c + 2; const int row0 = b * RPB + slot * 128;
            __syncthreads();
#pragma unroll
            for (int i = 0; i < 4; ++i) { const int idx = tid + i * NTHR, l = idx >> 4, n0 = (idx & 15) * 8; const bf16_t* rp = XBC + (size_t)(row0 + l) * 4096 + 2048 + g * 128 + n0;
                *(u32x4*)(Bs + rm_off(l, n0)) = *(const u32x4*)rp; *(u32x4*)(Cs + rm_off(l, n0)) = *(const u32x4*)(rp + 1024); }
#pragma unroll
            for (int i = 0; i < 2; ++i) { const int idx = tid + i * NTHR, hd = idx >> 7, l = idx & 127;
                fa[(hd >> 1) * 512 + 256 + (hd & 1) * 128 + l] = DT[(size_t)(row0 + l) * 64 + (hd & 1) * 32 + g * 4 + (hd >> 1)]; }
            LOADXH(g * 4); WRITEXH();
            __syncthreads();
            { const int hd = wave, hh = hd >> 1, dir = hd & 1; const float A = -__expf(a_log[dir * 32 + g * 4 + hh]) * 1.4426950408889634f;
              float le0, le1, tot, a0, a1; wave_scan128(fa + hh * 512 + 256 + dir * 128, lane, le0, le1, tot, a0, a1);
              const float c0 = (dir == 0 ? le0 : tot - le0 + a0) * A, c1 = (dir == 0 ? le1 : tot - le1 + a1) * A;
              *(f32x2*)(fa + hh * 512 + dir * 128 + 2 * lane) = (f32x2){c0, c1};
              *(f32x2*)(fb + hh * 256 + dir * 128 + 2 * lane) = (f32x2){c0 - __log2f(a0), c1 - __log2f(a1)}; }
            f32x16 ga[2] = {f32x16{}, f32x16{}};
#pragma unroll 2
            for (int ks = 0; ks < 8; ++ks) { const int k0 = ks * 16 + 8 * h;
                const bf16x8 cf = *(const bf16x8*)(Cs + rm_off(tl * 32 + r, k0));
#pragma unroll
                for (int t2 = 0; t2 < 2; ++t2) { const bf16x8 bf_ = *(const bf16x8*)(Bs + rm_off((tsb + t2) * 32 + r, k0)); ga[t2] = MFMA32(bf_, cf, ga[t2]); } }
            __syncthreads();
#pragma unroll 1
            for (int hh = 0; hh < 4; ++hh) {
                const int head = g * 4 + hh; const float* fh = fa + hh * 512;
                if (hh < 3) LOADXH(head + 1);
                { const int l = tl * 32 + r; const float cfl = fh[l], rcl = fh[128 + l]; const float* fbh = fb + hh * 256;
#pragma unroll
                  for (int t2 = 0; t2 < 2; ++t2) { const int ts = tsb + t2;
                    if (ts < tl) {
#pragma unroll
                        for (int q = 0; q < 4; ++q) { const int s0 = ts * 32 + 8 * q + 4 * h; const f32x4 cs = *(const f32x4*)(fbh + s0);
                            u32x2 w; w.x = cvt_pk_bf16(ga[t2][4 * q] * __builtin_amdgcn_exp2f(cfl - cs[0]), ga[t2][4 * q + 1] * __builtin_amdgcn_exp2f(cfl - cs[1]));
                            w.y = cvt_pk_bf16(ga[t2][4 * q + 2] * __builtin_amdgcn_exp2f(cfl - cs[2]), ga[t2][4 * q + 3] * __builtin_amdgcn_exp2f(cfl - cs[3]));
                            *(u32x2*)(Bs + rm_off(l, s0)) = w; }
                    } else if (ts > tl) {
#pragma unroll
                        for (int q = 0; q < 4; ++q) { const int s0 = ts * 32 + 8 * q + 4 * h; const f32x4 cs = *(const f32x4*)(fbh + 128 + s0);
                            u32x2 w; w.x = cvt_pk_bf16(ga[t2][4 * q] * __builtin_amdgcn_exp2f(rcl - cs[0]), ga[t2][4 * q + 1] * __builtin_amdgcn_exp2f(rcl - cs[1]));
                            w.y = cvt_pk_bf16(ga[t2][4 * q + 2] * __builtin_amdgcn_exp2f(rcl - cs[2]), ga[t2][4 * q + 3] * __builtin_amdgcn_exp2f(rcl - cs[3]));
                            *(u32x2*)(Bs + rm_off(l, s0)) = w; }
                    } else {
                        const float dsk = d_skip[head];
#pragma unroll
                        for (int q = 0; q < 4; ++q) { const int s0 = ts * 32 + 8 * q + 4 * h;
                            const f32x4 cfs = *(const f32x4*)(fbh + s0), rcs = *(const f32x4*)(fbh + 128 + s0);
                            float m[4];
#pragma unroll
                            for (int j = 0; j < 4; ++j) { const int s = s0 + j;
                                const float wf = s <= l ? __builtin_amdgcn_exp2f(cfl - cfs[j]) : 0.f;
                                const float wb = s >= l ? __builtin_amdgcn_exp2f(rcl - rcs[j]) : 0.f;
                                m[j] = ga[t2][4 * q + j] * (wf + wb) + (s == l ? dsk : 0.f); }
                            u32x2 w; w.x = cvt_pk_bf16(m[0], m[1]); w.y = cvt_pk_bf16(m[2], m[3]);
                            *(u32x2*)(Bs + rm_off(l, s0)) = w; }
                    } } }
                __syncthreads();
                {
                    const int tp = wave & 1;
                    f32x16 aD = f32x16{}, aF = f32x16{}, aB = f32x16{};
#pragma unroll 2
                    for (int ks = 0; ks < 8; ++ks) { const int k0 = ks * 16 + 8 * h;
                        const bf16x8 mf = *(const bf16x8*)(Bs + rm_off(tl * 32 + r, k0)), xf = *(const bf16x8*)(XT + tr_off(tp * 32 + r, k0));
                        const bf16x8 cf = *(const bf16x8*)(Cs + rm_off(tl * 32 + r, k0)), hf = *(const bf16x8*)(Hf + rm_off(tp * 32 + r, k0)), hb = *(const bf16x8*)(Hb + rm_off(tp * 32 + r, k0));
                        aD = MFMA32(mf, xf, aD); aF = MFMA32(cf, hf, aF); aB = MFMA32(cf, hb, aB); }
                    bf16_t* yp = P + (size_t)row0 * LDP + C_XBC + head * 64 + tp * 32 + r;
#pragma unroll
                    for (int i = 0; i < 16; ++i) { const int l = tl * 32 + att::crow(i, h);
                        const float y = aD[i] + __builtin_amdgcn_exp2f(fh[l]) * aF[i] + __builtin_amdgcn_exp2f(fh[128 + l]) * aB[i];
                        yp[(size_t)l * LDP] = f2bf(y); }
                }
                __syncthreads();
                if (hh < 3) WRITEXH();
            }
        }
#undef LOADXH
#undef WRITEXH
    }
    PROBE_END(6);
    if (IN(6) && IN(13)) { PROBE_BEGIN(13); PHASE_VARS PHASE_PTRS
        for (int u = bid; u < 512; u += G) {
            const int b = u >> 8, w = u & 255, xcd = w & 7, j = w >> 3, kvh = xcd >> 1, idx = (xcd & 1) * 32 + j, rep = idx >> 4, qb = idx & 15, head = kvh * 4 + rep;
            bf16_t* Qb = P + (size_t)(b * RPB + CTXL + qb * 256) * LDP + C_Q + head * 128;
            const bf16_t* Kh = P + (size_t)(b * RPB) * LDP + C_K + kvh * 128; const bf16_t* Vh = P + (size_t)(b * RPB) * LDP + C_V + kvh * 128;
            att::attn_dense_body(Qb, Kh, Vh, Qb, RPB, lds, tid, args.in[I_QN], qb * 256);
            __syncthreads();
        }
    }
    PROBE_END(13);
    do { if (IN(6) && IN(7)) xcd_barrier(xbar, wave_s == 0 && __builtin_amdgcn_mbcnt_hi(~0u, __builtin_amdgcn_mbcnt_lo(~0u, 0u)) == 0u); } while (0);

    if (IN(7)) { PROBE_BEGIN(7); PHASE_VARS PHASE_PTRS
        const float* ssmn = args.in[I_SSMN];
        for (int lr = gw; lr < ML; lr += ngw) {
            const int b = lr >> 12, t = lr & 4095; bf16_t* rowp = P + (size_t)(b * RPB + CTXL + t) * LDP;
            u32x2 yv[8], zv[8]; f32x4 nwv[8]; u32x2 ov[8];
#pragma unroll
            for (int g = 0; g < 8; ++g) { yv[g] = *(const u32x2*)(rowp + C_XBC + g * 256 + lane * 4); zv[g] = *(const u32x2*)(rowp + C_Z + g * 256 + lane * 4); nwv[g] = *(const f32x4*)(ssmn + g * 256 + lane * 4); }
            float vv[8][4], ssg[8];
#pragma unroll
            for (int g = 0; g < 8; ++g) {
                vv[g][0] = bflo(yv[g].x) * siluf_(bflo(zv[g].x)); vv[g][1] = bfhi(yv[g].x) * siluf_(bfhi(zv[g].x)); vv[g][2] = bflo(yv[g].y) * siluf_(bflo(zv[g].y)); vv[g][3] = bfhi(yv[g].y) * siluf_(bfhi(zv[g].y));
                ssg[g] = vv[g][0] * vv[g][0] + vv[g][1] * vv[g][1] + vv[g][2] * vv[g][2] + vv[g][3] * vv[g][3]; }
#pragma unroll
            for (int o = 32; o >= 1; o >>= 1) {
#pragma unroll
                for (int g = 0; g < 8; ++g) ssg[g] += __shfl_xor(ssg[g], o); }
#pragma unroll
            for (int g = 0; g < 8; ++g) { const float rstd = rsqrtf(ssg[g] * (1.f / 256.f) + EPS);
                ov[g].x = cvt_pk_bf16(vv[g][0] * rstd * nwv[g][0], vv[g][1] * rstd * nwv[g][1]); ov[g].y = cvt_pk_bf16(vv[g][2] * rstd * nwv[g][2], vv[g][3] * rstd * nwv[g][3]); }
#pragma unroll
            for (int g = 0; g < 8; ++g) st8_wt(rowp + C_Z + g * 256 + lane * 4, ov[g]);
        }
        __syncthreads();
        char* scr = lds + wave * 8448;
        transpose_matrix(args.in[I_WF1], DM, 2 * DFF, (bf16_t*)(ws + WS_WF1), 2 * DFF, [](int db) { const int pn = db >> 2, q = db & 3; return q < 2 ? pn * 128 + q * 64 : DFF + pn * 128 + (q - 2) * 64; }, scr, gw, ngw, lane);
        __syncthreads();
    }
    SEAM(7);

    if (IN(8)) { PROBE_BEGIN(8); PHASE_VARS PHASE_PTRS
        pg8::Sched S; S.init(32, 8, G, bid, 3);
        pg8::Gemm g{P + C_Z, (const bf16_t*)(ws + WS_WSSM), LDP, DM, DM, (size_t)(C_Q - C_Z) * 2};
        pg8::EpiMerge E{P};
        pg8::gemm_phase<pg8::EpiMerge>((LAS unsigned char*)lds_raw, g, S, E, tid);
    }
    SEAM(8);

    if (IN(9)) { PROBE_BEGIN(9); PHASE_VARS PHASE_PTRS
        pg8::Sched S; S.init(32, 8, G, bid, 1);
        pg8::Gemm g{P + C_G, (const bf16_t*)(ws + WS_WO), LDP, DM, DM};
        pg8::EpiResid<0> E{x, args.out, MOD, b_mod, 2 * DM};
        pg8::gemm_phase<pg8::EpiResid<0>>((LAS unsigned char*)lds_raw, g, S, E, tid);
    }
    SEAM(9);

    if (IN(10)) { PROBE_BEGIN(10); PHASE_VARS PHASE_PTRS
        bf16_t* XN2 = (bf16_t*)(ws + WS_XN2); const float* norm2 = args.in[I_NORM2];
        float* pl = (float*)lds;
        const int rpb = (ML + G - 1) / G;
        for (int r0 = bid * rpb; r0 < ML; r0 += G * rpb) {
            const int b = r0 >> 12;
            __syncthreads();
            for (int i = tid; i < DM; i += NTHR) { const float* mv = MOD + (size_t)b * NMOD;
                pl[i] = norm2[i] * (mv[4 * DM + i] + b_mod[4 * DM + i] + 1.f); pl[2048 + i] = mv[3 * DM + i] + b_mod[3 * DM + i]; }
            __syncthreads();
            const int rend = (r0 + rpb < ML) ? r0 + rpb : ML;
            for (int r = r0 + wave; r < rend; r += NWAVES) {
                const int rb = r >> 12; const float* src = args.out + (size_t)r * DM;
                f32x4 xv[8]; float ss = 0.f;
#pragma unroll
                for (int j = 0; j < 8; ++j) xv[j] = *(const f32x4*)(src + j * 256 + lane * 4);
#pragma unroll
                for (int j = 0; j < 8; ++j) ss += xv[j][0] * xv[j][0] + xv[j][1] * xv[j][1] + xv[j][2] * xv[j][2] + xv[j][3] * xv[j][3];
                const float rstd = rsqrtf(wave_sum(ss) * (1.f / DM) + EPS);
                if (rb == b) {
#pragma unroll
                    for (int j = 0; j < 8; ++j) { const int col = j * 256 + lane * 4;
                        const f32x4 o = xv[j] * rstd * *(const f32x4*)(pl + col) + *(const f32x4*)(pl + 2048 + col);
                        u32x2 w; w.x = cvt_pk_bf16(o[0], o[1]); w.y = cvt_pk_bf16(o[2], o[3]);
                        st8_wt(XN2 + (size_t)r * DM + col, w); }
                } else {
                    const float* mv = MOD + (size_t)rb * NMOD;
#pragma unroll
                    for (int j = 0; j < 8; ++j) { const int col = j * 256 + lane * 4;
                        const f32x4 nw = *(const f32x4*)(norm2 + col), sh = *(const f32x4*)(mv + 3 * DM + col) + *(const f32x4*)(b_mod + 3 * DM + col), sc = *(const f32x4*)(mv + 4 * DM + col) + *(const f32x4*)(b_mod + 4 * DM + col);
                        const f32x4 o = xv[j] * rstd * nw * (sc + 1.f) + sh;
                        u32x2 w; w.x = cvt_pk_bf16(o[0], o[1]); w.y = cvt_pk_bf16(o[2], o[3]);
                        st8_wt(XN2 + (size_t)r * DM + col, w); }
                }
            }
        }
    }
    SEAM(10);

    if (IN(11)) { PROBE_BEGIN(11); PHASE_VARS PHASE_PTRS
        pg8::Sched S; S.init(32, 44, G, bid, 0);
        pg8::Gemm g{(const bf16_t*)(ws + WS_XN2), (const bf16_t*)(ws + WS_WF1), DM, DM, DM};
        pg8::EpiSwiglu E{(bf16_t*)(ws + WS_HID)};
        pg8::gemm_phase<pg8::EpiSwiglu>((LAS unsigned char*)lds_raw, g, S, E, tid);
        {
            const int rounds = (S.total + G - 1) / G, last_cnt = S.total - (rounds - 1) * G, n_idle = G - last_cnt;
            const bool idle = n_idle > 0 ? (bid >= last_cnt) : true;
            if (idle) {
                const int gwi = n_idle > 0 ? (bid - last_cnt) * NWAVES + wave : gw, ngwi = n_idle > 0 ? n_idle * NWAVES : ngw;
                char* scr = lds + wave * 8448;
                transpose_matrix(args.in[I_WF2], DFF, DM, (bf16_t*)(ws + WS_WF2), DM, [](int db) { return db * 64; }, scr, gwi, ngwi, lane);
            }
        }
    }
    SEAM(11);

    if (IN(12)) { PROBE_BEGIN(12); PHASE_VARS PHASE_PTRS
        pg8::Sched S; S.init(32, 8, G, bid, 0);
        pg8::Gemm g{(const bf16_t*)(ws + WS_HID), (const bf16_t*)(ws + WS_WF2), DFF, DFF, DFF};
        pg8::EpiResid<1> E{args.out, args.out, MOD, b_mod, 5 * DM};
        pg8::gemm_phase<pg8::EpiResid<1>>((LAS unsigned char*)lds_raw, g, S, E, tid);
    }
    if (PROBE_MASK != 0 && bid == 0 && threadIdx.x == 0) { const unsigned t0 = (unsigned)__builtin_amdgcn_s_memrealtime(), wait = misc[3] * (unsigned)PROBE_MULT;
        while ((unsigned)__builtin_amdgcn_s_memrealtime() - t0 < wait) __builtin_amdgcn_s_sleep(8); }
#undef IN
#undef SEAM
}

constexpr int N_PHASES = 13;
#ifndef MK_PER_PHASE
#define MK_PER_PHASE 0
#endif
extern "C" void kernel_launch(void* const* d_in, const int* in_sizes, int n_in, void* d_out, int out_size, void* d_ws, size_t ws_size, hipStream_t stream) {
    static int grid = 0;
    if (grid == 0) {
        if (n_in != 22 || out_size != ML * DM || ws_size < WS_END) { fprintf(stderr, "kernel_launch: bad shapes n_in %d out %d ws %zu (need %zu)\n", n_in, out_size, ws_size, (size_t)WS_END); grid = -1; return; }
        int dev = 0, cus = 0, per_cu = 0;
        if (hipGetDevice(&dev) != hipSuccess || hipDeviceGetAttribute(&cus, hipDeviceAttributeMultiprocessorCount, dev) != hipSuccess) { grid = -1; return; }
        if (hipFuncSetAttribute((const void*)fwd_megakernel, hipFuncAttributeMaxDynamicSharedMemorySize, LDS_BYTES) != hipSuccess) { fprintf(stderr, "kernel_launch: hipFuncSetAttribute failed\n"); grid = -1; return; }
        if (hipOccupancyMaxActiveBlocksPerMultiprocessor(&per_cu, (const void*)fwd_megakernel, NTHR, LDS_BYTES) != hipSuccess || per_cu < 1) { fprintf(stderr, "kernel_launch: occupancy query says %d\n", per_cu); (void)hipGetLastError(); per_cu = 1; }
        grid = cus;
    }
    if (grid < 0) return;
    (void)hipMemsetAsync((char*)d_ws, 0, ZERO_BYTES, stream);
    Args a{};
    for (int i = 0; i < 22; ++i) a.in[i] = (const float*)d_in[i];
    a.out = (float*)d_out; a.ws = (unsigned char*)d_ws;
#if MK_PER_PHASE
    for (int p = 0; p < N_PHASES; ++p) { a.ph_lo = p; a.ph_hi = p + 1; hipLaunchKernelGGL(fwd_megakernel, dim3(grid), dim3(NTHR), LDS_BYTES, stream, a); }
#else
    a.ph_lo = 0; a.ph_hi = N_PHASES;
    void* kargs[] = {&a};
    hipError_t e = hipLaunchCooperativeKernel((const void*)fwd_megakernel, dim3(grid), dim3(NTHR), kargs, LDS_BYTES, stream);
    if (e != hipSuccess) fprintf(stderr, "kernel_launch: cooperative launch failed: %s (grid %d)\n", hipGetErrorString(e), grid);
#endif
}
```

```cpp
#include <hip/hip_runtime.h>
#include <hip/hip_cooperative_groups.h>
#include <cstdio>
#include <cstdint>
namespace cg = cooperative_groups;

#define DI __device__ __forceinline__
#define LAS __attribute__((address_space(3)))
typedef unsigned short bf16_t;
typedef short bf16x8 __attribute__((ext_vector_type(8)));
typedef short s16x4 __attribute__((ext_vector_type(4)));
typedef float f32x2 __attribute__((ext_vector_type(2)));
typedef float f32x4 __attribute__((ext_vector_type(4)));
typedef float f32x16 __attribute__((ext_vector_type(16)));
typedef unsigned u32x2 __attribute__((ext_vector_type(2)));
typedef unsigned u32x4 __attribute__((ext_vector_type(4)));

constexpr int DM = 2048, NB = 2, SEQ = 4096, CTXL = 256, RPB = SEQ + CTXL  , MP = NB * RPB  , ML = NB * SEQ;
constexpr int LDP = 13568;
constexpr int C_Z = 0, C_XBC = 2048, C_Q = 6144, C_K = 8192, C_V = 8704, C_G = 9216, C_DT = 13312;
constexpr int DFF = 5632, NMOD = 12288, NSLOT = 34;
constexpr float EPS = 1e-6f;
constexpr int NTHR = 512, NWAVES = 8;
constexpr int LDS_BYTES = 144 * 1024;

constexpr size_t al256(size_t x) { return (x + 255) / 256 * 256; }
constexpr size_t WS_CTL = 0;
constexpr size_t WS_MOD = 16384;
constexpr size_t ZERO_BYTES = WS_MOD + (size_t)3 * NMOD * 4;
constexpr size_t WS_DT  = al256(ZERO_BYTES);
constexpr size_t WS_DEC = al256(WS_DT + (size_t)MP * 64 * 4);
constexpr size_t WS_R1  = al256(WS_DEC + (size_t)NB * 2 * NSLOT * 32 * 4);
constexpr size_t SZ_WIN = (size_t)LDP * DM * 2;
constexpr size_t WS_WIN = WS_R1;
constexpr size_t WS_XN  = WS_R1 + SZ_WIN;
constexpr size_t SZ_R1  = SZ_WIN + (size_t)MP * DM * 2;
constexpr size_t WS_XBC = WS_R1;
constexpr size_t WS_XN2 = WS_R1;
constexpr size_t WS_R2  = al256(WS_R1 + SZ_R1);
constexpr size_t WS_WSSM = WS_R2, WS_WATT = WS_R2 + (size_t)DM * DM * 2, WS_WO = WS_R2 + (size_t)2 * DM * DM * 2;
constexpr size_t WS_R3  = al256(WS_R2 + (size_t)3 * DM * DM * 2);
constexpr size_t WS_P   = WS_R3;
constexpr size_t WS_HID = WS_R3;
constexpr size_t WS_R4  = al256(WS_R3 + (size_t)MP * LDP * 2);
constexpr size_t PLANE  = (size_t)32 * 64 * 128;
constexpr size_t WS_ST  = WS_R4;
constexpr size_t WS_WF1 = WS_R4;
constexpr size_t WS_WF2 = WS_R4 + (size_t)2 * DFF * DM * 2;
constexpr size_t WS_END = al256(WS_R4 + (size_t)NB * 2 * NSLOT * PLANE * 2);
static_assert((size_t)2 * DFF * DM * 2 + (size_t)DM * DFF * 2 <= (size_t)NB * 2 * NSLOT * PLANE * 2, "ffn weights fit the state region");
static_assert((size_t)MP * 4096 * 2 <= SZ_R1, "xbc fits r1");

DI unsigned cvt_pk_bf16(float lo, float hi) { unsigned r; asm volatile("v_cvt_pk_bf16_f32 %0, %1, %2" : "=v"(r) : "v"(lo), "v"(hi)); return r; }
DI float bflo(unsigned w) { return __uint_as_float(w << 16); }
DI float bfhi(unsigned w) { return __uint_as_float(w & 0xffff0000u); }
DI float bf2f(bf16_t b) { return __uint_as_float(((unsigned)b) << 16); }
DI bf16_t f2bf(float x) { return (bf16_t)(cvt_pk_bf16(x, 0.f) & 0xffffu); }
DI float wave_sum(float v) { for (int o = 32; o >= 1; o >>= 1) v += __shfl_xor(v, o); return v; }
DI void wave_scan128(const float* a, int lane, float& le0, float& le1, float& tot, float& a0, float& a1) {
    const f32x2 v = *(const f32x2*)(a + 2 * lane); a0 = v.x; a1 = v.y; float inc = a0 + a1;
#pragma unroll
    for (int o = 1; o < 64; o <<= 1) { const float t = __shfl_up(inc, o); inc += lane >= o ? t : 0.f; }
    le0 = inc - a1; le1 = inc; tot = __shfl(inc, 63);
}
DI float sigmoidf_(float x) { return __builtin_amdgcn_rcpf(1.f + __builtin_amdgcn_exp2f(-1.4426950408889634f * x)); }
DI float siluf_(float x) { return x * __builtin_amdgcn_rcpf(1.f + __builtin_amdgcn_exp2f(-1.4426950408889634f * x)); }
DI float softplusf_(float x) { return fmaxf(x, 0.f) + log1pf(__expf(-fabsf(x))); }

namespace pg8 {
constexpr int BM = 256, BK = 64, HALF = 128, HTB = HALF * BK * 2, STAGE_BYTES = 8 * HTB, NXCD = 8, WGM = 8;
DI int lds_byte(int r, int c) { const int st = (r >> 4) * 2 + (c >> 5), rr = r & 15, cc = c & 31, ob = rr * 64 + cc * 2; return st * 1024 + (ob ^ (((ob >> 9) & 1) << 5)); }
DI void stage_rc(int b, int& R, int& C) { const int st = b / 1024, sb = b % 1024, swz = sb ^ (((sb >> 9) & 1) << 5); R = (st >> 1) * 16 + swz / 64; C = (st & 1) * 32 + (swz % 64) / 2; }
DI int perm32(int rho) { const int n = rho >> 4, i = rho & 15; return 8 * (i >> 2) + 4 * n + (i & 3); }
struct Unit { int pm, pn; };
struct Gemm { const bf16_t* A; const bf16_t* Bt; int lda, ldb, K; size_t a_alt; };
struct Sched {
    int nM, nN, nwg, G, c, mode, total;
    DI void init(int nM_, int nN_, int G_, int c_, int mode_) { nM = nM_; nN = nN_; nwg = nM * nN; G = G_; c = c_; mode = mode_; total = nwg + (mode == 2 ? 42 : 0); }
    DI bool next(int i, Unit& u) const {
        int which = 0; if (mode == 3) { which = i & 1; i >>= 1; }
        const int L = i * G + c; if (L >= total) return false;
        if (L >= nwg) { const int j = L - nwg, t = j / 21, q = j % 21; u.pm = t * 17; u.pn = q < 16 ? 8 + q : (q < 20 ? 32 + (q - 16) : 52); return true; }
        int wgid = L; { const int q = nwg / NXCD, r = nwg % NXCD, xcd = wgid % NXCD, off = wgid / NXCD; wgid = (xcd < r ? xcd * (q + 1) : r * (q + 1) + (xcd - r) * q) + off; }
        const int nig = WGM * nN, gid = wgid / nig, fm = gid * WGM, gsz = (nM - fm) < WGM ? (nM - fm) : WGM;
        int pm = fm + ((wgid % nig) % gsz); const int pn = (wgid % nig) / gsz;
        if (mode) pm = pm + 1 + (pm >= 16 ? 1 : 0);
        u.pm = pm; u.pn = pn + 8 * which; return true;
    }
};

template <class Epi>
DI void gemm_phase(LAS unsigned char* lds, const Gemm g, const Sched& S, const Epi& E, int tid) {
    asm volatile("" : "+v"(tid));
    const int wid = __builtin_amdgcn_readfirstlane(tid >> 6), lane = tid & 63, wr = wid >> 2, wc = wid & 3, fr = lane & 15, fq = lane >> 4;
    const int K = g.K, nt = K / BK;
    unsigned voffA[2], voffB[2];
#pragma unroll
    for (int i = 0; i < 2; ++i) { int R, C; stage_rc(tid * 16 + i * 8192, R, C); const int Rb = Epi::PERM ? ((R & ~31) + perm32(R & 31)) : R;
        voffA[i] = (unsigned)(R * g.lda + C) * 2u; voffB[i] = (unsigned)(Rb * g.ldb + C) * 2u; }
    const size_t kstep = (size_t)(BK * 2);
    const size_t hstepA = (size_t)HALF * g.lda * 2, hstepB = (size_t)HALF * g.ldb * 2;
    const size_t tstepA = 2 * hstepA, tstepB = 2 * hstepB;
    const unsigned ldsw = (unsigned)wid * 1024u;
    const int aoff = lds_byte(wr * 64 + fr, fq * 8), boff = lds_byte(wc * 32 + fr, fq * 8);
#define PG8_SA(b, h) (((b) * 2 + (h)) * HTB)
#define PG8_SB(b, h) ((4 + (b) * 2 + (h)) * HTB)
#define PG8_STAGE(bufoff, gbase, voff) do { _Pragma("unroll") for (int _i = 0; _i < 2; ++_i) \
        __builtin_amdgcn_global_load_lds((const unsigned*)((const char*)(gbase) + (voff)[_i]), (LAS unsigned*)(lds + (bufoff) + ldsw + _i * 8192), 16, 0, 0); } while (0)
#define PG8_LDA(dst, b, h) do { _Pragma("unroll") for (int m = 0; m < 4; ++m) _Pragma("unroll") for (int k = 0; k < 2; ++k) dst[m][k] = *(const LAS bf16x8*)(lds + PG8_SA(b, h) + aoff + m * 2048 + k * 1024); } while (0)
#define PG8_LDB(dst, b, h) do { _Pragma("unroll") for (int n = 0; n < 2; ++n) _Pragma("unroll") for (int k = 0; k < 2; ++k) dst[n][k] = *(const LAS bf16x8*)(lds + PG8_SB(b, h) + boff + n * 2048 + k * 1024); } while (0)
#define PG8_MMA(ai, bj, At, Bt) do { __builtin_amdgcn_s_setprio(1); _Pragma("unroll") for (int m = 0; m < 4; ++m) _Pragma("unroll") for (int n = 0; n < 2; ++n) _Pragma("unroll") for (int k = 0; k < 2; ++k) \
        acc[ai][bj][m][n] = __builtin_amdgcn_mfma_f32_16x16x32_bf16(Bt[n][k], At[m][k], acc[ai][bj][m][n], 0, 0, 0); __builtin_amdgcn_s_setprio(0); } while (0)
#define PG8_WAIT_V(n) asm volatile("s_waitcnt vmcnt(" #n ")" ::: "memory")
#define PG8_WAIT_L(n) asm volatile("s_waitcnt lgkmcnt(" #n ")" ::: "memory")
#define PG8_BAR __builtin_amdgcn_s_barrier()
#define PG8_SCHED __builtin_amdgcn_sched_barrier(0)
    Unit cur, nxt; int ui = 0;
    if (!S.next(0, cur)) return;
    f32x4 acc[2][2][4][2];
#pragma unroll
    for (int a = 0; a < 2; ++a)
#pragma unroll
        for (int b = 0; b < 2; ++b)
#pragma unroll
            for (int m = 0; m < 4; ++m)
#pragma unroll
                for (int n = 0; n < 2; ++n) acc[a][b][m][n] = (f32x4){0.f, 0.f, 0.f, 0.f};
    bf16x8 At[4][2], B0[2][2], B1[2][2];
    const char* cA = (const char*)g.A + (size_t)cur.pm * tstepA + (cur.pn >= 8 ? g.a_alt : (size_t)0); const char* cB = (const char*)g.Bt + (size_t)cur.pn * tstepB;
    PG8_STAGE(PG8_SB(0, 0), cB, voffB); PG8_STAGE(PG8_SA(0, 0), cA, voffA); PG8_STAGE(PG8_SB(0, 1), cB + hstepB, voffB); PG8_STAGE(PG8_SA(0, 1), cA + hstepA, voffA);
    if (wr == 1) PG8_BAR;
    PG8_WAIT_V(4); PG8_BAR;
    PG8_STAGE(PG8_SB(1, 0), cB + kstep, voffB); PG8_STAGE(PG8_SA(1, 0), cA + kstep, voffA); PG8_STAGE(PG8_SB(1, 1), cB + hstepB + kstep, voffB);
    PG8_WAIT_V(6); PG8_BAR;
    for (;;) {
        const bool has_next = S.next(ui + 1, nxt);
        const char* nA = has_next ? (const char*)g.A + (size_t)nxt.pm * tstepA + (nxt.pn >= 8 ? g.a_alt : (size_t)0) : cA; const char* nB = has_next ? (const char*)g.Bt + (size_t)nxt.pn * tstepB : cB;
        for (int t = 0; t < nt; t += 2) {
            const bool last = (t == nt - 2);
            const char* a1 = cA + (size_t)(t + 1) * kstep;
            const char* a2 = last ? nA : cA + (size_t)(t + 2) * kstep; const char* b2 = last ? nB : cB + (size_t)(t + 2) * kstep;
            const char* a3 = a2 + kstep; const char* b3 = b2 + kstep;
            PG8_LDB(B0, 0, 0); PG8_SCHED; PG8_LDA(At, 0, 0); PG8_STAGE(PG8_SA(1, 1), a1 + hstepA, voffA);
            PG8_WAIT_L(8); PG8_BAR; PG8_WAIT_L(0); PG8_MMA(0, 0, At, B0); PG8_BAR; PG8_SCHED;
            PG8_LDB(B1, 0, 1); PG8_STAGE(PG8_SB(0, 0), b2, voffB);
            PG8_BAR; PG8_WAIT_L(0); PG8_MMA(0, 1, At, B1); PG8_BAR;
            PG8_LDA(At, 0, 1); PG8_STAGE(PG8_SA(0, 0), a2, voffA);
            PG8_BAR; PG8_WAIT_L(0); PG8_MMA(1, 0, At, B0); PG8_BAR; PG8_SCHED;
            PG8_STAGE(PG8_SB(0, 1), b2 + hstepB, voffB);
            PG8_WAIT_V(6); PG8_BAR; PG8_MMA(1, 1, At, B1); PG8_BAR;
            PG8_LDB(B0, 1, 0); PG8_SCHED; PG8_LDA(At, 1, 0); PG8_STAGE(PG8_SA(0, 1), a2 + hstepA, voffA);
            PG8_WAIT_L(8); PG8_BAR; PG8_WAIT_L(0); PG8_MMA(0, 0, At, B0); PG8_BAR; PG8_SCHED;
            PG8_LDB(B1, 1, 1); PG8_STAGE(PG8_SB(1, 0), b3, voffB);
            PG8_BAR; PG8_WAIT_L(0); PG8_MMA(0, 1, At, B1); PG8_BAR;
            PG8_LDA(At, 1, 1); PG8_STAGE(PG8_SA(1, 0), a3, voffA);
            PG8_BAR; PG8_WAIT_L(0); PG8_MMA(1, 0, At, B0); PG8_BAR; PG8_SCHED;
            PG8_STAGE(PG8_SB(1, 1), b3 + hstepB, voffB);
            PG8_WAIT_V(6); PG8_BAR; PG8_MMA(1, 1, At, B1); PG8_BAR;
        }
        bool keep_acc = false;
        if constexpr (Epi::CHAIN) { if (cur.pn < 8) { E.mid(acc, cur, wr, wc, fr, fq); keep_acc = true; } else E(acc, cur, wr, wc, fr, fq); }
        else E(acc, cur, wr, wc, fr, fq);
        if (!has_next) break;
        if (!keep_acc)
#pragma unroll
        for (int a = 0; a < 2; ++a)
#pragma unroll
            for (int b = 0; b < 2; ++b)
#pragma unroll
                for (int m = 0; m < 4; ++m)
#pragma unroll
                    for (int n = 0; n < 2; ++n) acc[a][b][m][n] = (f32x4){0.f, 0.f, 0.f, 0.f};
        cur = nxt; cA = nA; cB = nB; ++ui;
    }
    PG8_WAIT_V(0);
    if (wr == 0) PG8_BAR;
    PG8_BAR;
#undef PG8_SA
#undef PG8_SB
#undef PG8_STAGE
#undef PG8_LDA
#undef PG8_LDB
#undef PG8_MMA
#undef PG8_WAIT_V
#undef PG8_WAIT_L
#undef PG8_BAR
#undef PG8_SCHED
}

struct EpiInProj {
    static constexpr bool PERM = true, CHAIN = false;
    bf16_t* P; float* DT; const float* dt_bias;
    DI void operator()(const f32x4 (&acc)[2][2][4][2], const Unit& u, int wr, int wc, int fr, int fq) const {
        const int row0 = u.pm * BM + wr * 64 + fr;
        if (u.pn < 52) {
            const int col0 = u.pn * BM + wc * 32 + 8 * fq;
#pragma unroll
            for (int ai = 0; ai < 2; ++ai)
#pragma unroll
                for (int m = 0; m < 4; ++m) { bf16_t* rowp = P + (size_t)(row0 + ai * HALF + m * 16) * LDP + col0;
#pragma unroll
                    for (int bj = 0; bj < 2; ++bj) { const f32x4 v0 = acc[ai][bj][m][0], v1 = acc[ai][bj][m][1];
                        u32x4 w; w.x = cvt_pk_bf16(v0[0], v0[1]); w.y = cvt_pk_bf16(v0[2], v0[3]); w.z = cvt_pk_bf16(v1[0], v1[1]); w.w = cvt_pk_bf16(v1[2], v1[3]);
                        *(u32x4*)(rowp + bj * HALF) = w; } }
        } else if (wc < 2) {
            const int c0 = wc * 32 + 8 * fq;
#pragma unroll
            for (int ai = 0; ai < 2; ++ai)
#pragma unroll
                for (int m = 0; m < 4; ++m) { float* rowp = DT + (size_t)(row0 + ai * HALF + m * 16) * 64 + c0;
#pragma unroll
                    for (int n = 0; n < 2; ++n) { f32x4 v = acc[ai][0][m][n];
#pragma unroll
                        for (int j = 0; j < 4; ++j) v[j] = softplusf_(v[j] + dt_bias[c0 + 4 * n + j]);
                        *(f32x4*)(rowp + 4 * n) = v; } }
        }
    }
};
template <int SECOND> struct EpiBranch {
    static constexpr bool PERM = true, CHAIN = false;
    bf16_t* P;
    DI void operator()(const f32x4 (&acc)[2][2][4][2], const Unit& u, int wr, int wc, int fr, int fq) const {
        const int row0 = u.pm * BM + wr * 64 + fr, col0 = C_G + u.pn * BM + wc * 32 + 8 * fq;
#pragma unroll
        for (int aim = 0; aim < 4; ++aim) { const int ai = aim >> 1, m0 = (aim & 1) * 2;
            u32x4 gwv[4][2], pwv[4][2];
#pragma unroll
            for (int m = m0; m < m0 + 2; ++m) { const bf16_t* rowp = P + (size_t)(row0 + ai * HALF + m * 16) * LDP + col0;
#pragma unroll
                for (int bj = 0; bj < 2; ++bj) { gwv[m][bj] = *(const u32x4*)(rowp + bj * HALF + (SECOND ? DM : 0)); if (SECOND) pwv[m][bj] = *(const u32x4*)(rowp + bj * HALF); } }
#pragma unroll
            for (int m = m0; m < m0 + 2; ++m) { bf16_t* rowp = P + (size_t)(row0 + ai * HALF + m * 16) * LDP + col0;
#pragma unroll
                for (int bj = 0; bj < 2; ++bj) { const f32x4 v0 = acc[ai][bj][m][0], v1 = acc[ai][bj][m][1];
                    const u32x4 gw = gwv[m][bj];
                    float r[8];
                    r[0] = sigmoidf_(bflo(gw.x)) * v0[0]; r[1] = sigmoidf_(bfhi(gw.x)) * v0[1]; r[2] = sigmoidf_(bflo(gw.y)) * v0[2]; r[3] = sigmoidf_(bfhi(gw.y)) * v0[3];
                    r[4] = sigmoidf_(bflo(gw.z)) * v1[0]; r[5] = sigmoidf_(bfhi(gw.z)) * v1[1]; r[6] = sigmoidf_(bflo(gw.w)) * v1[2]; r[7] = sigmoidf_(bfhi(gw.w)) * v1[3];
                    if (SECOND) { const u32x4 pw = pwv[m][bj];
                        r[0] += bflo(pw.x); r[1] += bfhi(pw.x); r[2] += bflo(pw.y); r[3] += bfhi(pw.y); r[4] += bflo(pw.z); r[5] += bfhi(pw.z); r[6] += bflo(pw.w); r[7] += bfhi(pw.w); }
                    u32x4 w; w.x = cvt_pk_bf16(r[0], r[1]); w.y = cvt_pk_bf16(r[2], r[3]); w.z = cvt_pk_bf16(r[4], r[5]); w.w = cvt_pk_bf16(r[6], r[7]);
                    *(u32x4*)(rowp + bj * HALF) = w; } }
            asm volatile("" ::: "memory");
        }
    }
};
template <int INP> struct EpiResid {
    static constexpr bool PERM = false, CHAIN = false;
    const float* base; float* out; const float* mod; const float* b_mod; int goff;
    DI void operator()(const f32x4 (&acc)[2][2][4][2], const Unit& u, int wr, int wc, int fr, int fq) const {
        const int b = INP ? (u.pm >= 16 ? 1 : 0) : (u.pm >= 17 ? 1 : 0);
        const int lat0 = (INP ? u.pm * BM : u.pm * BM - 256 * (b + 1)) + wr * 64 + fr, col0 = u.pn * BM + wc * 32 + 4 * fq;
        f32x4 gv[2][2];
#pragma unroll
        for (int bj = 0; bj < 2; ++bj)
#pragma unroll
            for (int n = 0; n < 2; ++n) gv[bj][n] = *(const f32x4*)(mod + (size_t)b * NMOD + goff + col0 + bj * HALF + n * 16) + *(const f32x4*)(b_mod + goff + col0 + bj * HALF + n * 16);
#pragma unroll
        for (int aim = 0; aim < 4; ++aim) { const int ai = aim >> 1, m0 = (aim & 1) * 2;
            f32x4 bsv[4][2][2];
#pragma unroll
            for (int m = m0; m < m0 + 2; ++m) { const size_t off = (size_t)(lat0 + ai * HALF + m * 16) * DM + col0;
#pragma unroll
                for (int bj = 0; bj < 2; ++bj)
#pragma unroll
                    for (int n = 0; n < 2; ++n) bsv[m][bj][n] = *(const f32x4*)(base + off + bj * HALF + n * 16); }
#pragma unroll
            for (int m = m0; m < m0 + 2; ++m) { const size_t off = (size_t)(lat0 + ai * HALF + m * 16) * DM + col0;
#pragma unroll
                for (int bj = 0; bj < 2; ++bj)
#pragma unroll
                    for (int n = 0; n < 2; ++n) *(f32x4*)(out + off + bj * HALF + n * 16) = bsv[m][bj][n] + gv[bj][n] * acc[ai][bj][m][n]; }
            asm volatile("" ::: "memory");
        }
    }
};
struct EpiMerge {
    static constexpr bool PERM = true, CHAIN = true;
    bf16_t* P;
    static DI float eneg(float g) { return __builtin_amdgcn_exp2f(fminf(-1.4426950408889634f * g, 64.f)); }
    DI void mid(f32x4 (&acc)[2][2][4][2], const Unit& u, int wr, int wc, int fr, int fq) const {
        const int row0 = u.pm * BM + wr * 64 + fr, col0 = C_G + u.pn * BM + wc * 32 + 8 * fq;
#pragma unroll
        for (int aim = 0; aim < 4; ++aim) { const int ai = aim >> 1, m0 = (aim & 1) * 2;
            u32x4 g1v[4][2], g2v[4][2];
#pragma unroll
            for (int m = m0; m < m0 + 2; ++m) { const bf16_t* rowp = P + (size_t)(row0 + ai * HALF + m * 16) * LDP + col0;
#pragma unroll
                for (int bj = 0; bj < 2; ++bj) { g1v[m][bj] = *(const u32x4*)(rowp + bj * HALF); g2v[m][bj] = *(const u32x4*)(rowp + bj * HALF + DM); } }
#pragma unroll
            for (int m = m0; m < m0 + 2; ++m)
#pragma unroll
                for (int bj = 0; bj < 2; ++bj) { const u32x4 a = g1v[m][bj], c = g2v[m][bj];
                    const float g1[8] = {bflo(a.x), bfhi(a.x), bflo(a.y), bfhi(a.y), bflo(a.z), bfhi(a.z), bflo(a.w), bfhi(a.w)};
                    const float g2[8] = {bflo(c.x), bfhi(c.x), bflo(c.y), bfhi(c.y), bflo(c.z), bfhi(c.z), bflo(c.w), bfhi(c.w)};
#pragma unroll
                    for (int j = 0; j < 8; ++j) { const float ratio = (1.f + eneg(g2[j])) * __builtin_amdgcn_rcpf(1.f + eneg(g1[j])); acc[ai][bj][m][j >> 2][j & 3] *= ratio; } }
            asm volatile("" ::: "memory");
        }
    }
    DI void operator()(const f32x4 (&acc)[2][2][4][2], const Unit& u, int wr, int wc, int fr, int fq) const {
        const int row0 = u.pm * BM + wr * 64 + fr, col0 = C_G + (u.pn - 8) * BM + wc * 32 + 8 * fq;
#pragma unroll
        for (int aim = 0; aim < 4; ++aim) { const int ai = aim >> 1, m0 = (aim & 1) * 2;
            u32x4 g2v[4][2];
#pragma unroll
            for (int m = m0; m < m0 + 2; ++m) { const bf16_t* rowp = P + (size_t)(row0 + ai * HALF + m * 16) * LDP + col0;
#pragma unroll
                for (int bj = 0; bj < 2; ++bj) g2v[m][bj] = *(const u32x4*)(rowp + bj * HALF + DM); }
#pragma unroll
            for (int m = m0; m < m0 + 2; ++m) { bf16_t* rowp = P + (size_t)(row0 + ai * HALF + m * 16) * LDP + col0;
#pragma unroll
                for (int bj = 0; bj < 2; ++bj) { const u32x4 c = g2v[m][bj]; const f32x4 v0 = acc[ai][bj][m][0], v1 = acc[ai][bj][m][1];
                    const float g2[8] = {bflo(c.x), bfhi(c.x), bflo(c.y), bfhi(c.y), bflo(c.z), bfhi(c.z), bflo(c.w), bfhi(c.w)};
                    float r[8];
#pragma unroll
                    for (int j = 0; j < 8; ++j) r[j] = (j < 4 ? v0[j & 3] : v1[j & 3]) * __builtin_amdgcn_rcpf(1.f + eneg(g2[j]));
                    u32x4 w; w.x = cvt_pk_bf16(r[0], r[1]); w.y = cvt_pk_bf16(r[2], r[3]); w.z = cvt_pk_bf16(r[4], r[5]); w.w = cvt_pk_bf16(r[6], r[7]);
                    *(u32x4*)(rowp + bj * HALF) = w; } }
            asm volatile("" ::: "memory");
        }
    }
};
struct EpiSwiglu {
    static constexpr bool PERM = true, CHAIN = false;
    bf16_t* H;
    DI void operator()(const f32x4 (&acc)[2][2][4][2], const Unit& u, int wr, int wc, int fr, int fq) const {
        const int row0 = u.pm * BM + wr * 64 + fr, col0 = u.pn * HALF + wc * 32 + 8 * fq;
#pragma unroll
        for (int ai = 0; ai < 2; ++ai)
#pragma unroll
            for (int m = 0; m < 4; ++m) { bf16_t* rowp = H + (size_t)(row0 + ai * HALF + m * 16) * DFF + col0;
                const f32x4 g0 = acc[ai][0][m][0], g1 = acc[ai][0][m][1], u0 = acc[ai][1][m][0], u1 = acc[ai][1][m][1];
                u32x4 w; w.x = cvt_pk_bf16(siluf_(g0[0]) * u0[0], siluf_(g0[1]) * u0[1]); w.y = cvt_pk_bf16(siluf_(g0[2]) * u0[2], siluf_(g0[3]) * u0[3]);
                w.z = cvt_pk_bf16(siluf_(g1[0]) * u1[0], siluf_(g1[1]) * u1[1]); w.w = cvt_pk_bf16(siluf_(g1[2]) * u1[2], siluf_(g1[3]) * u1[3]);
                *(u32x4*)rowp = w; asm volatile("" ::: "memory"); }
    }
};
}

namespace att {
constexpr int D = 128, NW = 8, QBLK = 32, KVBLK = 64;
constexpr float SCALE = 0.088388347648318440f;
constexpr float THR = 8.f;
constexpr int LDQ = LDP, LDK = LDP, LDO = LDP;
constexpr size_t SHM_V = KVBLK * D * 2, SHM_K = KVBLK * D * 2, SHM_ATTN = 2 * SHM_V + 2 * SHM_K + NW * 64 * 4;
#define KSWZ(row, colB) ((row) * 256 + ((colB) ^ (((row) & 7) << 4)))
#define SBAR() __builtin_amdgcn_sched_barrier(0)
DI int crow(int r, int hi) { return (r & 3) + 8 * (r >> 2) + 4 * hi; }
DI unsigned cvtpk(float lo, float hi) { unsigned r; asm volatile("v_cvt_pk_bf16_f32 %0, %1, %2" : "=v"(r) : "v"(lo), "v"(hi)); return r; }
DI bf16x8 ld8(const bf16_t* p) { return *reinterpret_cast<const bf16x8*>(p); }
DI void partialSM(f32x16& p0, f32x16& p1, float& m_reg, float& mn, float& alpha) {
  constexpr float C = SCALE * 1.4426950408889634f;
  float pmax = p0[0]; for (int r = 1; r < 16; ++r) pmax = fmaxf(pmax, p0[r]); for (int r = 0; r < 16; ++r) pmax = fmaxf(pmax, p1[r]);
  { auto rr = __builtin_amdgcn_permlane32_swap(__float_as_uint(pmax), __float_as_uint(pmax), false, false);
    pmax = fmaxf(__uint_as_float(rr[0]), __uint_as_float(rr[1])); }
  if (__builtin_expect(__all(pmax - m_reg <= THR / SCALE), 1)) { mn = m_reg; alpha = 1.f; }
  else { mn = fmaxf(m_reg, pmax); alpha = __builtin_amdgcn_exp2f((m_reg - mn) * C); m_reg = mn; }
  float mnC = -mn * C;
  for (int r = 0; r < 16; ++r) p0[r] = fmaf(p0[r], C, mnC); for (int r = 0; r < 16; ++r) p1[r] = fmaf(p1[r], C, mnC);
  for (int r = 0; r < 16; ++r) p0[r] = __builtin_amdgcn_exp2f(p0[r]);
}
DI void finishSM(f32x16& p0, f32x16& p1, float alpha, float& l_reg, bf16x8& pa0, bf16x8& pa1, bf16x8& pa2, bf16x8& pa3) {
  for (int r = 0; r < 16; ++r) p1[r] = __builtin_amdgcn_exp2f(p1[r]);
  float ps = 0; for (int r = 0; r < 16; ++r) ps += p0[r]; for (int r = 0; r < 16; ++r) ps += p1[r];
  { auto rr = __builtin_amdgcn_permlane32_swap(__float_as_uint(ps), __float_as_uint(ps), false, false);
    ps = __uint_as_float(rr[0]) + __uint_as_float(rr[1]); }
  l_reg = l_reg * alpha + ps;
#define PK4(P, BASE, OUT) do { unsigned a0 = cvtpk(P[BASE + 0], P[BASE + 1]), a1 = cvtpk(P[BASE + 2], P[BASE + 3]);   \
    unsigned b0 = cvtpk(P[BASE + 4], P[BASE + 5]), b1 = cvtpk(P[BASE + 6], P[BASE + 7]);                              \
    auto r0 = __builtin_amdgcn_permlane32_swap(a0, b0, false, false); auto r1 = __builtin_amdgcn_permlane32_swap(a1, b1, false, false); \
    u32x4 w = {r0[0], r1[0], r0[1], r1[1]}; OUT = *reinterpret_cast<bf16x8*>(&w); } while (0)
  PK4(p0, 0, pa0); PK4(p0, 8, pa1); PK4(p1, 0, pa2); PK4(p1, 8, pa3);
#undef PK4
}
DI void qkt(f32x16& p0, f32x16& p1, const bf16_t* Ks, const bf16x8* qr, int r32, int hi) {
  p0 = f32x16{}; p1 = f32x16{};
  for (int d0 = 0; d0 < 8; ++d0) { int cb = (d0 * 16 + hi * 8) * 2;
    bf16x8 b0 = *reinterpret_cast<const bf16x8*>((const char*)Ks + KSWZ(r32, cb));
    bf16x8 b1 = *reinterpret_cast<const bf16x8*>((const char*)Ks + KSWZ(32 + r32, cb));
    p0 = __builtin_amdgcn_mfma_f32_32x32x16_bf16(b0, qr[d0], p0, 0, 0, 0);
    p1 = __builtin_amdgcn_mfma_f32_32x32x16_bf16(b1, qr[d0], p1, 0, 0, 0); }
}
DI int v_st(int k, int c) { const int kk = (k & ~0xC) | ((k & 4) << 1) | ((k & 8) >> 1); return ((kk >> 3) * 4 + (c >> 5)) * 512 + ((kk & 7) * 32 + (c & 31)) * 2; }
DI int v_rd_base(int lane) { return ((lane & 3) << 3) | (((lane >> 2) & 3) << 6) | (((lane >> 4) & 1) << 5) | (((lane >> 5) & 1) << 8); }
constexpr int v_rd_off(int d0, int ks, int half) { return d0 * 512 + ks * 4096 + half * 2048; }
template <int OFF> DI s16x4 tr_read(int vb) {
  s16x4 r; asm volatile("ds_read_b64_tr_b16 %0, %1 offset:%2" : "=&v"(r) : "v"(vb), "i"(OFF) : "memory"); return r;
}
template <int D0> DI void pv_one(f32x16& od, int vb, bf16x8 pa0, bf16x8 pa1, bf16x8 pa2, bf16x8 pa3) {
  const s16x4 l0 = tr_read<v_rd_off(D0, 0, 0)>(vb), h0 = tr_read<v_rd_off(D0, 0, 1)>(vb), l1 = tr_read<v_rd_off(D0, 1, 0)>(vb), h1 = tr_read<v_rd_off(D0, 1, 1)>(vb);
  const s16x4 l2 = tr_read<v_rd_off(D0, 2, 0)>(vb), h2 = tr_read<v_rd_off(D0, 2, 1)>(vb), l3 = tr_read<v_rd_off(D0, 3, 0)>(vb), h3 = tr_read<v_rd_off(D0, 3, 1)>(vb);
  asm volatile("s_waitcnt lgkmcnt(0)" ::: "memory"); SBAR();
#define PK(L, H) (bf16x8){L[0], L[1], L[2], L[3], H[0], H[1], H[2], H[3]}
  od = __builtin_amdgcn_mfma_f32_32x32x16_bf16(pa0, PK(l0, h0), od, 0, 0, 0);
  od = __builtin_amdgcn_mfma_f32_32x32x16_bf16(pa1, PK(l1, h1), od, 0, 0, 0);
  od = __builtin_amdgcn_mfma_f32_32x32x16_bf16(pa2, PK(l2, h2), od, 0, 0, 0);
  od = __builtin_amdgcn_mfma_f32_32x32x16_bf16(pa3, PK(l3, h3), od, 0, 0, 0);
#undef PK
}
DI void pv_d0(f32x16* o, int vb, bf16x8 pa0, bf16x8 pa1, bf16x8 pa2, bf16x8 pa3) {
  pv_one<0>(o[0], vb, pa0, pa1, pa2, pa3); pv_one<1>(o[1], vb, pa0, pa1, pa2, pa3); pv_one<2>(o[2], vb, pa0, pa1, pa2, pa3); pv_one<3>(o[3], vb, pa0, pa1, pa2, pa3);
}
DI void attn_dense_body(const bf16_t* __restrict__ Qb, const bf16_t* __restrict__ Kh, const bf16_t* __restrict__ Vh, bf16_t* Ob, int seq, char* lds, int tid, const float* __restrict__ qnw, int t0) {
  asm volatile("" : "+v"(tid));
  const int wid = tid >> 6, lane = tid & 63, r32 = lane & 31, hi = lane >> 5;
  bf16_t* V_lds = (bf16_t*)lds; bf16_t* K_lds = (bf16_t*)(lds + 2 * SHM_V);
  float* ws = (float*)(lds + 2 * SHM_V + 2 * SHM_K) + wid * 64; float* li_l = ws; float* al_l = ws + 32;
  float m_reg = -1e30f, l_reg = 0; f32x16 o[4] = {}; bf16x8 qr[8];
  const bf16_t* Qw = Qb + (long)(wid * QBLK + r32) * LDQ + hi * 8;
  {
    float qf[8][8]; float ssq = 0.f;
#pragma unroll
    for (int d0 = 0; d0 < 8; ++d0) { const u32x4 w = *reinterpret_cast<const u32x4*>(Qw + d0 * 16);
      qf[d0][0] = bflo(w.x); qf[d0][1] = bfhi(w.x); qf[d0][2] = bflo(w.y); qf[d0][3] = bfhi(w.y); qf[d0][4] = bflo(w.z); qf[d0][5] = bfhi(w.z); qf[d0][6] = bflo(w.w); qf[d0][7] = bfhi(w.w); }
#pragma unroll
    for (int d0 = 0; d0 < 8; ++d0)
#pragma unroll
      for (int j = 0; j < 8; ++j) ssq += qf[d0][j] * qf[d0][j];
    { auto rr = __builtin_amdgcn_permlane32_swap(__float_as_uint(ssq), __float_as_uint(ssq), false, false); ssq = __uint_as_float(rr[0]) + __uint_as_float(rr[1]); }
    const float rstd = rsqrtf(ssq * (1.f / 128.f) + EPS);
    const int tok = t0 + wid * QBLK + r32; const float posr = (float)(tok >> 6), posc = (float)(tok & 63);
#pragma unroll
    for (int d0 = 0; d0 < 8; ++d0) { const f32x4 wa = *reinterpret_cast<const f32x4*>(qnw + d0 * 16 + hi * 8), wb = *reinterpret_cast<const f32x4*>(qnw + d0 * 16 + hi * 8 + 4);
      qf[d0][0] *= rstd * wa[0]; qf[d0][1] *= rstd * wa[1]; qf[d0][2] *= rstd * wa[2]; qf[d0][3] *= rstd * wa[3]; qf[d0][4] *= rstd * wb[0]; qf[d0][5] *= rstd * wb[1]; qf[d0][6] *= rstd * wb[2]; qf[d0][7] *= rstd * wb[3]; }
#pragma unroll
    for (int q = 0; q < 4; ++q) { const int da = (q >> 1) * 4 + (q & 1), db = da + 2; const float pos = (q >> 1) ? posc : posr;
#pragma unroll
      for (int j = 0; j < 8; ++j) { const int f = (da & 1) * 16 + hi * 8 + j;
        float rev = pos * (exp2f(-(float)f * (13.287712379549449f / 32.f)) * 0.15915494309189535f); rev = rev - floorf(rev);
        const float cs = __builtin_amdgcn_cosf(rev), sn = __builtin_amdgcn_sinf(rev), n1 = qf[da][j], n2 = qf[db][j];
        qf[da][j] = n1 * cs - n2 * sn; qf[db][j] = n2 * cs + n1 * sn; } }
#pragma unroll
    for (int d0 = 0; d0 < 8; ++d0) { u32x4 w = {cvtpk(qf[d0][0], qf[d0][1]), cvtpk(qf[d0][2], qf[d0][3]), cvtpk(qf[d0][4], qf[d0][5]), cvtpk(qf[d0][6], qf[d0][7])}; qr[d0] = *reinterpret_cast<bf16x8*>(&w); }
  }
  const int sr = tid >> 4, sc = (tid & 15) * 8, vst0 = v_st(sr, sc), vst1 = v_st(32 + sr, sc);
  const int vb0 = (int)(uintptr_t)V_lds + v_rd_base(lane);
  constexpr int SDEPTH = 1;
  struct { bf16x8 vs0, vs1, ks0, ks1; } sr_[SDEPTH];
#define SLOAD(i, k0) do { sr_[i].vs0 = ld8(&Vh[(long)((k0) + sr) * LDK + sc]); sr_[i].vs1 = ld8(&Vh[(long)((k0) + 32 + sr) * LDK + sc]); \
    sr_[i].ks0 = ld8(&Kh[(long)((k0) + sr) * LDK + sc]); sr_[i].ks1 = ld8(&Kh[(long)((k0) + 32 + sr) * LDK + sc]); } while (0)
#define SWRITE(b, i) do { *(bf16x8*)((char*)V_lds + (b) * SHM_V + vst0) = sr_[i].vs0;          \
    *(bf16x8*)((char*)V_lds + (b) * SHM_V + vst1) = sr_[i].vs1; int kc = sc * 2;               \
    *(bf16x8*)((char*)K_lds + (b) * SHM_K + KSWZ(sr, kc)) = sr_[i].ks0;                       \
    *(bf16x8*)((char*)K_lds + (b) * SHM_K + KSWZ(32 + sr, kc)) = sr_[i].ks1; } while (0)
#define SWAIT() do { if constexpr (SDEPTH == 2) asm volatile("s_waitcnt vmcnt(4)" ::: "memory"); else asm volatile("s_waitcnt vmcnt(0)" ::: "memory"); } while (0)
#define RESC(a) do { if (__any((a) < 1.f)) { if (hi == 0) al_l[r32] = (a); asm volatile("s_waitcnt lgkmcnt(0)" ::: "memory"); \
    for (int d = 0; d < 4; ++d) for (int r = 0; r < 16; ++r) o[d][r] *= al_l[crow(r, hi)]; } } while (0)
  f32x16 pA0, pA1, pB0, pB1; float mnA, mnB, alA, alB; bf16x8 pa0, pa1, pa2, pa3; const int NT = seq / KVBLK;
  constexpr int SE = 0, SO = SDEPTH - 1;
  SLOAD(SE, 0); asm volatile("s_waitcnt vmcnt(0)" ::: "memory"); SWRITE(0, SE); __syncthreads();
  qkt(pA0, pA1, K_lds, qr, r32, hi); partialSM(pA0, pA1, m_reg, mnA, alA);
  SLOAD(SO, KVBLK); if constexpr (SDEPTH == 2) { if (2 < NT) SLOAD(SE, 2 * KVBLK); }
  SWAIT(); SWRITE(1, SO); __syncthreads();
  for (int j = 1; j + 1 < NT; j += 2) {
    SBAR(); qkt(pB0, pB1, (bf16_t*)((char*)K_lds + SHM_K), qr, r32, hi);
    finishSM(pA0, pA1, alA, l_reg, pa0, pa1, pa2, pa3); SBAR();
    SLOAD(SO, (j + SDEPTH) * KVBLK); SBAR();
    pv_d0(o, vb0, pa0, pa1, pa2, pa3); partialSM(pB0, pB1, m_reg, mnB, alB);
    __syncthreads(); SWAIT(); SWRITE(0, SE);
    RESC(alB); __syncthreads();
    SBAR(); qkt(pA0, pA1, K_lds, qr, r32, hi);
    finishSM(pB0, pB1, alB, l_reg, pa0, pa1, pa2, pa3); SBAR();
    if (SDEPTH == 1 || j + 3 < NT) SLOAD(SE, (j + 1 + SDEPTH) * KVBLK); SBAR();
    pv_d0(o, vb0 + (int)SHM_V, pa0, pa1, pa2, pa3); partialSM(pA0, pA1, m_reg, mnA, alA);
    __syncthreads(); SWAIT(); SWRITE(1, SO);
    RESC(alA); __syncthreads();
  }
  SBAR(); qkt(pB0, pB1, (bf16_t*)((char*)K_lds + SHM_K), qr, r32, hi);
  finishSM(pA0, pA1, alA, l_reg, pa0, pa1, pa2, pa3); SBAR();
  pv_d0(o, vb0, pa0, pa1, pa2, pa3); partialSM(pB0, pB1, m_reg, mnB, alB);
  __syncthreads(); RESC(alB);
  finishSM(pB0, pB1, alB, l_reg, pa0, pa1, pa2, pa3); SBAR();
  pv_d0(o, vb0 + (int)SHM_V, pa0, pa1, pa2, pa3);
  if (hi == 0) li_l[r32] = l_reg; asm volatile("s_waitcnt lgkmcnt(0)" ::: "memory");
  float rli[16];
#pragma unroll
  for (int r = 0; r < 16; ++r) rli[r] = __builtin_amdgcn_rcpf(li_l[crow(r, hi)]);
  bf16_t* Ow = Ob + (long)(wid * QBLK) * LDO;
#pragma unroll
  for (int r = 0; r < 16; ++r) { int orow = crow(r, hi);
    for (int d0 = 0; d0 < 4; ++d0) Ow[(long)orow * LDO + d0 * 32 + r32] = f2bf(o[d0][r] * rli[r]); }
#undef SLOAD
#undef SWRITE
#undef SWAIT
#undef RESC
}
}

#define XB_TMO      128
#define XB_XCNT(j)  (256  + 64 * (j))
#define XB_XSUB(j)  (1280 + 64 * (j))
#define XB_XGEN(j)  (2304 + 64 * (j))
#define XB_TOP      3328
#define XB_TOPGEN   3392
#define XCD_BAR_WORDS 3456
#define XB_SPIN_CAP (1u << 18)
DI unsigned xb_ld(unsigned* p)              { return __hip_atomic_load(p, __ATOMIC_RELAXED, __HIP_MEMORY_SCOPE_AGENT); }
DI unsigned xb_add(unsigned* p, unsigned v) { return __hip_atomic_fetch_add(p, v, __ATOMIC_RELAXED, __HIP_MEMORY_SCOPE_AGENT); }
DI unsigned xb_xcc_id() { return (unsigned)__builtin_amdgcn_s_getreg((3 << 11) | 20) & 0xFu; }
#define XB_SPIN(cond, bar) do { unsigned _sp = 0; while (cond) { __builtin_amdgcn_s_sleep(1); \
    if ((++_sp & 255u) == 0u) { if (xb_ld(&(bar)[XB_TMO])) break; if (_sp > XB_SPIN_CAP) { atomicAdd(&(bar)[XB_TMO], 1u); break; } } } } while (0)
struct XcdBarrier { unsigned* bar; unsigned x; volatile LAS unsigned* st; };
DI XcdBarrier xcd_barrier_post(unsigned* bar, volatile LAS unsigned* st) {
    XcdBarrier b; b.bar = bar; b.x = xb_xcc_id(); b.st = st;
    if (threadIdx.x == 0) (void)xb_add(&bar[XB_XCNT(b.x)], 1u);
    return b;
}
DI void xcd_barrier_complete(unsigned* bar, unsigned x, unsigned& nloc, unsigned& nx) {
    const unsigned G = gridDim.x * gridDim.y * gridDim.z;
    unsigned sum, cnt, mine, sp = 0u;
    for (;;) {
        sum = 0u; cnt = 0u; mine = 0u;
#pragma unroll
        for (unsigned j = 0; j < 16; ++j) { const unsigned c = xb_ld(&bar[XB_XCNT(j)]); sum += c; cnt += (c > 0u) ? 1u : 0u; mine = (j == x) ? c : mine; }
        if (sum == G) break;
        __builtin_amdgcn_s_sleep(1);
        if ((++sp & 255u) == 0u) { if (xb_ld(&bar[XB_TMO])) break; if (sp > XB_SPIN_CAP) { atomicAdd(&bar[XB_TMO], 1u); break; } }
    }
    nloc = mine > 0u ? mine : 1u; nx = cnt > 0u ? cnt : 1u;
}
DI void xcd_barrier(const XcdBarrier& b, bool leader) {
    asm volatile("s_waitcnt vmcnt(0)" ::: "memory");
    __syncthreads();
    if (leader) {
        unsigned* bar = b.bar;
        __builtin_amdgcn_s_waitcnt(0);
        unsigned nloc = b.st[0], nx = b.st[1];
        if (nloc == 0u) { xcd_barrier_complete(bar, b.x, nloc, nx); b.st[0] = nloc; b.st[1] = nx; }
        const unsigned old = xb_add(&bar[XB_XSUB(b.x)], 1u);
        const unsigned gen = old / nloc;
        if (old + 1u == (gen + 1u) * nloc) {
            __builtin_amdgcn_fence(__ATOMIC_RELEASE, "agent");
            asm volatile("s_waitcnt vmcnt(0)" ::: "memory");
            const unsigned og = xb_add(&bar[XB_TOP], 1u);
            const unsigned tg = og / nx;
            if (og + 1u == (tg + 1u) * nx) xb_add(&bar[XB_TOPGEN], 1u);
            else XB_SPIN(xb_ld(&bar[XB_TOPGEN]) == tg, bar);
            __builtin_amdgcn_fence(__ATOMIC_ACQUIRE, "agent");
            xb_add(&bar[XB_XGEN(b.x)], 1u);
            asm volatile("s_waitcnt vmcnt(0)" ::: "memory");
        } else {
            XB_SPIN(xb_ld(&bar[XB_XGEN(b.x)]) == gen, bar);
            __builtin_amdgcn_fence(__ATOMIC_ACQUIRE, "agent");
            asm volatile("s_waitcnt vmcnt(0)" ::: "memory");
        }
    }
    __syncthreads();
}
static_assert(XCD_BAR_WORDS * 4 <= WS_MOD, "barrier words fit the zeroed control region");

struct Args { const float* in[22]; float* out; unsigned char* ws; int ph_lo, ph_hi; };
enum { I_X = 0, I_C, I_CTX, I_CCTX, I_WMOD, I_BMOD, I_NORM1, I_WIN, I_CONVW, I_CONVB, I_DTB, I_ALOG, I_DSKIP, I_SSMN, I_QN, I_KN, I_WSSM, I_WATT, I_WO, I_NORM2, I_WF1, I_WF2 };

DI void transpose_item(const float* src, int ldw, bf16_t* dst, int ldt, char* scr, int lane) {
    if (src == nullptr) {
#pragma unroll
        for (int i = 0; i < 8; ++i) { const int n = i * 8 + (lane >> 3), k = (lane & 7) * 8; *(u32x4*)(dst + (size_t)n * ldt + k) = (u32x4){0u, 0u, 0u, 0u}; }
        return;
    }
    f32x4 v[16];
#pragma unroll
    for (int i = 0; i < 16; ++i) { const int k = i * 4 + (lane >> 4), n = (lane & 15) * 4; v[i] = *(const f32x4*)(src + (size_t)k * ldw + n); }
#pragma unroll
    for (int i = 0; i < 16; ++i) { const int k = i * 4 + (lane >> 4), n = (lane & 15) * 4;
        *(unsigned*)(scr + (k * 66 + n) * 2) = cvt_pk_bf16(v[i][0], v[i][1]); *(unsigned*)(scr + (k * 66 + n + 2) * 2) = cvt_pk_bf16(v[i][2], v[i][3]); }
    asm volatile("s_waitcnt lgkmcnt(0)" ::: "memory");
#pragma unroll
    for (int i = 0; i < 8; ++i) { const int n = i * 8 + (lane >> 3), k = (lane & 7) * 8;
        unsigned short e[8];
#pragma unroll
        for (int j = 0; j < 8; ++j) e[j] = *(const unsigned short*)(scr + ((k + j) * 66 + n) * 2);
        u32x4 w; w.x = e[0] | ((unsigned)e[1] << 16); w.y = e[2] | ((unsigned)e[3] << 16); w.z = e[4] | ((unsigned)e[5] << 16); w.w = e[6] | ((unsigned)e[7] << 16);
        *(u32x4*)(dst + (size_t)n * ldt + k) = w; }
    asm volatile("s_waitcnt lgkmcnt(0)" ::: "memory");
}
template <class F> DI void transpose_matrix(const float* W, int K, int N, bf16_t* Wt, int nd, F srccol, char* scr, int gw, int ngw, int lane) {
    const int kb = K / 64, items = (nd / 64) * kb;
    for (int it = gw; it < items; it += ngw) { const int db = it / kb, k0 = (it % kb) * 64; const int sc = srccol(db);
        transpose_item(sc < 0 ? nullptr : W + (size_t)k0 * N + sc, N, Wt + (size_t)db * 64 * K + k0, K, scr, lane); }
}

DI int rm_off(int row, int col) { return row * 272 + col * 2; }
DI int tr_off(int row, int col) { return row * 272 + ((((col >> 3) ^ (row >> 3)) & 15) << 4) + ((col & 7) << 1); }
#define MFMA32(a, b, c) __builtin_amdgcn_mfma_f32_32x32x16_bf16((a), (b), (c), 0, 0, 0)

__global__ void __launch_bounds__(NTHR, 2) fwd_megakernel(Args args) {
    extern __shared__ __attribute__((aligned(16))) unsigned char lds_raw[];
    cg::grid_group grid = cg::this_grid();
    char* lds = (char*)lds_raw;
    const int G = gridDim.x, bid = blockIdx.x, ngw = G * NWAVES;
    const int wave_s = __builtin_amdgcn_readfirstlane((int)threadIdx.x >> 6);
#define PHASE_VARS int tid = wave_s * 64 + (int)__builtin_amdgcn_mbcnt_hi(~0u, __builtin_amdgcn_mbcnt_lo(~0u, 0u)); asm volatile("" : "+v"(tid)); const int lane = tid & 63, wave = tid >> 6, gw = bid * NWAVES + wave; (void)lane; (void)wave; (void)gw; unsigned char* ws = args.ws; asm volatile("" : "+s"(ws));
    unsigned char* ws0 = args.ws;
#define PHASE_PTRS const float* x = args.in[I_X]; const float* b_mod = args.in[I_BMOD]; \
    float* MOD = (float*)(ws + WS_MOD); float* DT = (float*)(ws + WS_DT); float* DEC = (float*)(ws + WS_DEC); \
    bf16_t* P = (bf16_t*)(ws + WS_P); bf16_t* XBC = (bf16_t*)(ws + WS_XBC); bf16_t* ST = (bf16_t*)(ws + WS_ST); \
    (void)x; (void)b_mod; (void)MOD; (void)DT; (void)DEC; (void)P; (void)XBC; (void)ST; (void)ws0;
    const int lo = args.ph_lo, hi = args.ph_hi;
#ifndef PH_MASK
#define PH_MASK 0xFFFF
#endif
#define IN(k) (((PH_MASK >> (k)) & 1) && ((k) == 13 || (lo <= (k) && (k) < hi)))
#ifndef PROBE_MASK
#define PROBE_MASK 0
#endif
#ifndef PROBE_MULT
#define PROBE_MULT 4
#endif
    volatile LAS unsigned* misc = (volatile LAS unsigned*)(lds_raw + LDS_BYTES - 32);
    if (threadIdx.x == 0) { misc[0] = 0u; misc[1] = 0u; misc[2] = 0u; misc[3] = 0u; }
    __syncthreads();
    XcdBarrier xbar = xcd_barrier_post((unsigned*)(ws0 + WS_CTL), misc);
    if (lo < 0) grid.sync();
#define PROBE_BEGIN(k) do { if (((PROBE_MASK >> (k)) & 1) && bid == 0 && threadIdx.x == 0) misc[2] = (unsigned)__builtin_amdgcn_s_memrealtime(); } while (0)
#define PROBE_END(k) do { if (((PROBE_MASK >> (k)) & 1) && bid == 0 && threadIdx.x == 0) misc[3] = misc[3] + ((unsigned)__builtin_amdgcn_s_memrealtime() - misc[2]); } while (0)
#define SEAM(k) do { if (IN(k) && IN((k) + 1)) xcd_barrier(xbar, wave_s == 0 && __builtin_amdgcn_mbcnt_hi(~0u, __builtin_amdgcn_mbcnt_lo(~0u, 0u)) == 0u); PROBE_END(k); } while (0)

    if (IN(0)) { PROBE_BEGIN(0); PHASE_VARS PHASE_PTRS
        char* scr = lds + wave * 8448;
        transpose_matrix(args.in[I_WIN], DM, 13376, (bf16_t*)(ws + WS_WIN), LDP, [](int db) { const int n = db * 64; return n < 6144 ? n : (n < 13312 ? n + 64 : (n < 13376 ? n - 13312 + 6144 : -1)); }, scr, gw, ngw, lane);
        __syncthreads();
        float* sv = (float*)lds;
        for (int it = bid; it < 256; it += G) {
            const int ng = it & 7, kg = it >> 3;
            __syncthreads();
            if (tid < 192) { const int v = tid >> 6, kk = tid & 63, k = kg * 64 + kk; const float cv = v < 2 ? args.in[I_C][v * DM + k] : args.in[I_CCTX][k]; sv[tid] = siluf_(cv); }
            __syncthreads();
            if (tid < 384) {
                const int col = ng * 1536 + tid * 4; const float* wp = args.in[I_WMOD] + (size_t)(kg * 64) * NMOD + col;
                f32x4 a0 = {0.f, 0.f, 0.f, 0.f}, a1 = a0, a2 = a0;
#pragma unroll 8
                for (int kk = 0; kk < 64; ++kk) { const f32x4 w = *(const f32x4*)(wp + (size_t)kk * NMOD); a0 += w * sv[kk]; a1 += w * sv[64 + kk]; a2 += w * sv[128 + kk]; }
#pragma unroll
                for (int j = 0; j < 4; ++j) { atomicAdd(MOD + col + j, a0[j]); atomicAdd(MOD + NMOD + col + j, a1[j]); atomicAdd(MOD + 2 * NMOD + col + j, a2[j]); }
            }
        }
    }
    SEAM(0);

    if (IN(1)) { PROBE_BEGIN(1); PHASE_VARS PHASE_PTRS
        bf16_t* XN = (bf16_t*)(ws + WS_XN); const float* norm1 = args.in[I_NORM1];
        float* pl = (float*)lds;
        const int rpb = (MP + G - 1) / G;
        for (int r0 = bid * rpb; r0 < MP; r0 += G * rpb) {
            const int b = r0 / RPB;
            __syncthreads();
            for (int i = tid; i < 2 * DM; i += NTHR) { const int var = i >> 11, col = i & (DM - 1); const float* mv = MOD + (size_t)(var ? 2 : b) * NMOD;
                const float nw = norm1[col]; pl[var * 4096 + col] = nw * (mv[DM + col] + b_mod[DM + col] + 1.f); pl[var * 4096 + 2048 + col] = mv[col] + b_mod[col]; }
            __syncthreads();
            const int rend = (r0 + rpb < MP) ? r0 + rpb : MP;
            for (int r = r0 + wave; r < rend; r += NWAVES) {
                const int rb = r / RPB, t = r % RPB; const int var = t < CTXL ? 1 : 0;
                const float* src = t < CTXL ? args.in[I_CTX] + (size_t)(rb * CTXL + t) * DM : x + (size_t)(rb * SEQ + t - CTXL) * DM;
                f32x4 xv[8]; float ss = 0.f;
#pragma unroll
                for (int j = 0; j < 8; ++j) xv[j] = *(const f32x4*)(src + j * 256 + lane * 4);
#pragma unroll
                for (int j = 0; j < 8; ++j) ss += xv[j][0] * xv[j][0] + xv[j][1] * xv[j][1] + xv[j][2] * xv[j][2] + xv[j][3] * xv[j][3];
                const float rstd = rsqrtf(wave_sum(ss) * (1.f / DM) + EPS);
                if (rb == b) {
#pragma unroll
                    for (int j = 0; j < 8; ++j) { const int col = j * 256 + lane * 4;
                        const f32x4 o = xv[j] * rstd * *(const f32x4*)(pl + var * 4096 + col) + *(const f32x4*)(pl + var * 4096 + 2048 + col);
                        u32x2 w; w.x = cvt_pk_bf16(o[0], o[1]); w.y = cvt_pk_bf16(o[2], o[3]);
                        *(u32x2*)(XN + (size_t)r * DM + col) = w; }
                } else {
                    const float* mv = MOD + (size_t)(var ? 2 : rb) * NMOD;
#pragma unroll
                    for (int j = 0; j < 8; ++j) { const int col = j * 256 + lane * 4;
                        const f32x4 nw = *(const f32x4*)(norm1 + col), sh = *(const f32x4*)(mv + col) + *(const f32x4*)(b_mod + col), sc = *(const f32x4*)(mv + DM + col) + *(const f32x4*)(b_mod + DM + col);
                        const f32x4 o = xv[j] * rstd * nw * (sc + 1.f) + sh;
                        u32x2 w; w.x = cvt_pk_bf16(o[0], o[1]); w.y = cvt_pk_bf16(o[2], o[3]);
                        *(u32x2*)(XN + (size_t)r * DM + col) = w; }
                }
            }
        }
    }
    SEAM(1);

    if (IN(2)) { PROBE_BEGIN(2); PHASE_VARS PHASE_PTRS
        pg8::Gemm g{(const bf16_t*)(ws + WS_XN), (const bf16_t*)(ws + WS_WIN), DM, DM, DM};
        pg8::Sched S; S.init(32, 53, G, bid, 2);
        pg8::EpiInProj E{P, DT, args.in[I_DTB]};
        pg8::gemm_phase<pg8::EpiInProj>((LAS unsigned char*)lds_raw, g, S, E, tid);
        {
            const int rounds = (S.total + G - 1) / G, last_cnt = S.total - (rounds - 1) * G, n_idle = G - last_cnt;
            const bool idle = n_idle > 0 ? (bid >= last_cnt) : true;
            if (idle) {
                const int gwi = n_idle > 0 ? (bid - last_cnt) * NWAVES + wave : gw, ngwi = n_idle > 0 ? n_idle * NWAVES : ngw;
                char* scr = lds + wave * 8448;
                transpose_matrix(args.in[I_WSSM], DM, DM, (bf16_t*)(ws + WS_WSSM), DM, [](int db) { return db * 64; }, scr, gwi, ngwi, lane);
                transpose_matrix(args.in[I_WATT], DM, DM, (bf16_t*)(ws + WS_WATT), DM, [](int db) { return db * 64; }, scr, gwi, ngwi, lane);
                transpose_matrix(args.in[I_WO], DM, DM, (bf16_t*)(ws + WS_WO), DM, [](int db) { return db * 64; }, scr, gwi, ngwi, lane);
            }
        }
    }
    SEAM(2);

    if (IN(3)) { PROBE_BEGIN(3); PHASE_VARS PHASE_PTRS
        const float* cw = args.in[I_CONVW]; const float* cb = args.in[I_CONVB];
        const int gt = bid * NTHR + tid, ngt = G * NTHR;
        float w[5][8], bias[8];
        { const int ch = (gt & 511) * 8;
#pragma unroll
            for (int j = 0; j < 5; ++j) { const f32x4 a = *(const f32x4*)(cw + j * 4096 + ch), c2 = *(const f32x4*)(cw + j * 4096 + ch + 4);
                w[j][0] = a[0]; w[j][1] = a[1]; w[j][2] = a[2]; w[j][3] = a[3]; w[j][4] = c2[0]; w[j][5] = c2[1]; w[j][6] = c2[2]; w[j][7] = c2[3]; }
            { const f32x4 a = *(const f32x4*)(cb + ch), c2 = *(const f32x4*)(cb + ch + 4); bias[0] = a[0]; bias[1] = a[1]; bias[2] = a[2]; bias[3] = a[3]; bias[4] = c2[0]; bias[5] = c2[1]; bias[6] = c2[2]; bias[7] = c2[3]; } }
        for (int it = gt; it < 512 * 512; it += ngt) {
            const int cg8 = it & 511, rb = it >> 9, ch = cg8 * 8, r0 = rb * 17;
            const bf16_t* src = P + C_XBC + ch;
            u32x4 rw[21];
#pragma unroll
            for (int k = 0; k < 21; ++k) { const int rr = r0 - 2 + k; rw[k] = (rr >= 0 && rr < MP) ? *(const u32x4*)(src + (size_t)rr * LDP) : (u32x4){0u, 0u, 0u, 0u}; }
#pragma unroll
            for (int i = 0; i < 17; ++i) {
                const int ro = r0 + i; const int so = (ro / RPB) * 2 + ((ro % RPB) >= CTXL ? 1 : 0);
                float o[8];
#pragma unroll
                for (int e = 0; e < 8; ++e) o[e] = bias[e];
#pragma unroll
                for (int j = 0; j < 5; ++j) { const int rt = ro + j - 2; const int rtc = rt < 0 ? 0 : rt;
                    const bool ok = rt >= 0 && rt < MP && ((rtc / RPB) * 2 + ((rtc % RPB) >= CTXL ? 1 : 0)) == so;
                    if (ok) { const u32x4 q = rw[i + j];
                        o[0] += w[j][0] * bflo(q.x); o[1] += w[j][1] * bfhi(q.x); o[2] += w[j][2] * bflo(q.y); o[3] += w[j][3] * bfhi(q.y);
                        o[4] += w[j][4] * bflo(q.z); o[5] += w[j][5] * bfhi(q.z); o[6] += w[j][6] * bflo(q.w); o[7] += w[j][7] * bfhi(q.w); } }
                u32x4 ov; ov.x = cvt_pk_bf16(siluf_(o[0]), siluf_(o[1])); ov.y = cvt_pk_bf16(siluf_(o[2]), siluf_(o[3])); ov.z = cvt_pk_bf16(siluf_(o[4]), siluf_(o[5])); ov.w = cvt_pk_bf16(siluf_(o[6]), siluf_(o[7]));
                *(u32x4*)(XBC + (size_t)ro * 4096 + ch) = ov;
            }
        }
        const int sec = lane >> 5, f = lane & 31, e0 = sec * 64 + f, e1 = e0 + 32;
        const float qn0 = args.in[I_QN][e0], qn1 = args.in[I_QN][e1], kn0 = args.in[I_KN][e0], kn1 = args.in[I_KN][e1];
        const float inv_rev = exp2f(-(float)f * (13.287712379549449f / 32.f)) * 0.15915494309189535f;
        for (int r = gw; r < MP; r += ngw) {
            const int t = r % RPB; const bool lat = t >= CTXL; const int tl = t - CTXL;
            float cs = 1.f, sn = 0.f;
            if (lat) { const float pos = (float)(sec == 0 ? (tl >> 6) : (tl & 63)); float rev = pos * inv_rev; rev = rev - floorf(rev); cs = __builtin_amdgcn_cosf(rev); sn = __builtin_amdgcn_sinf(rev); }
            bf16_t* rowp = P + (size_t)r * LDP;
            if (lat) {
                float v0[4], v1[4], ss[4];
#pragma unroll
                for (int k = 0; k < 4; ++k) { const bf16_t* hp = rowp + C_K + k * 128; v0[k] = bf2f(hp[e0]); v1[k] = bf2f(hp[e1]); ss[k] = v0[k] * v0[k] + v1[k] * v1[k]; }
#pragma unroll
                for (int o = 32; o >= 1; o >>= 1) {
#pragma unroll
                    for (int k = 0; k < 4; ++k) ss[k] += __shfl_xor(ss[k], o); }
#pragma unroll
                for (int k = 0; k < 4; ++k) { bf16_t* hp = rowp + C_K + k * 128;
                    const float rstd = rsqrtf(ss[k] * (1.f / 128.f) + EPS);
                    const float n0 = v0[k] * rstd * kn0, n1 = v1[k] * rstd * kn1;
                    hp[e0] = f2bf(n0 * cs - n1 * sn); hp[e1] = f2bf(n1 * cs + n0 * sn); }
            } else {
                float v0[4], v1[4], ss[4];
#pragma unroll
                for (int k = 0; k < 4; ++k) { const bf16_t* hp = rowp + C_K + k * 128; v0[k] = bf2f(hp[e0]); v1[k] = bf2f(hp[e1]); ss[k] = v0[k] * v0[k] + v1[k] * v1[k]; }
#pragma unroll
                for (int k = 0; k < 4; ++k) ss[k] = wave_sum(ss[k]);
#pragma unroll
                for (int k = 0; k < 4; ++k) { bf16_t* hp = rowp + C_K + k * 128; const float rstd = rsqrtf(ss[k] * (1.f / 128.f) + EPS);
                    hp[e0] = f2bf(v0[k] * rstd * kn0); hp[e1] = f2bf(v1[k] * rstd * kn1); }
            }
        }
    }
    SEAM(3);

    if (IN(4)) { PROBE_BEGIN(4); PHASE_VARS PHASE_PTRS
        char* BT = lds;
        char* XT = lds + 34816;
        float* dtv = (float*)(lds + 104448);
        float* wv = dtv + 1024;
        const float* a_log = args.in[I_ALOG];
        for (int it = bid; it < NB * NSLOT * 8; it += G) {
            const int g = it & 7, slot = (it >> 3) % NSLOT, b = it / (8 * NSLOT); const int row0 = b * RPB + slot * 128;
            __syncthreads();
#pragma unroll
            for (int i = 0; i < 4; ++i) { const int idx = tid + i * NTHR, l = idx >> 4, n0 = (idx & 15) * 8;
                const u32x4 q = *(const u32x4*)(XBC + (size_t)(row0 + l) * 4096 + 2048 + g * 128 + n0);
                const unsigned short e[8] = {(unsigned short)q.x, (unsigned short)(q.x >> 16), (unsigned short)q.y, (unsigned short)(q.y >> 16), (unsigned short)q.z, (unsigned short)(q.z >> 16), (unsigned short)q.w, (unsigned short)(q.w >> 16)};
#pragma unroll
                for (int j = 0; j < 8; ++j) *(unsigned short*)(BT + tr_off(n0 + j, l)) = e[j]; }
#pragma unroll
            for (int i = 0; i < 8; ++i) { const int idx = tid + i * NTHR, l = idx >> 5, p0 = (idx & 31) * 8;
                const u32x4 q = *(const u32x4*)(XBC + (size_t)(row0 + l) * 4096 + g * 256 + p0);
                const unsigned short e[8] = {(unsigned short)q.x, (unsigned short)(q.x >> 16), (unsigned short)q.y, (unsigned short)(q.y >> 16), (unsigned short)q.z, (unsigned short)(q.z >> 16), (unsigned short)q.w, (unsigned short)(q.w >> 16)};
#pragma unroll
                for (int j = 0; j < 8; ++j) *(unsigned short*)(XT + tr_off(p0 + j, l)) = e[j]; }
#pragma unroll
            for (int i = 0; i < 2; ++i) { const int idx = tid + i * NTHR, hd = idx >> 7, l = idx & 127, dir = hd >> 2, hh = hd & 3;
                dtv[idx] = DT[(size_t)(row0 + l) * 64 + dir * 32 + g * 4 + hh]; }
            __syncthreads();
            { const int hd = wave, dir = hd >> 2, hh = hd & 3; const float A = -__expf(a_log[dir * 32 + g * 4 + hh]);
              float le0, le1, tot, a0, a1; wave_scan128(dtv + hd * 128, lane, le0, le1, tot, a0, a1);
              const float e0 = dir == 0 ? tot - le0 : le0 - a0, e1 = dir == 0 ? tot - le1 : le1 - a1;
              *(f32x2*)(wv + hd * 128 + 2 * lane) = (f32x2){__expf(e0 * A) * a0, __expf(e1 * A) * a1};
              if (lane == 0) DEC[((size_t)(b * 2 + dir) * NSLOT + slot) * 32 + g * 4 + hh] = __expf(tot * A); }
            __syncthreads();
            const int hh = wave >> 1, dir = wave & 1, hd = dir * 4 + hh, r = lane & 31, h = lane >> 5;
            f32x16 acc[2][4];
#pragma unroll
            for (int a = 0; a < 2; ++a)
#pragma unroll
                for (int c = 0; c < 4; ++c) acc[a][c] = f32x16{};
#pragma unroll 2
            for (int ks = 0; ks < 8; ++ks) {
                const int k0 = ks * 16 + 8 * h;
                const f32x4 w0 = *(const f32x4*)(wv + hd * 128 + k0), w1 = *(const f32x4*)(wv + hd * 128 + k0 + 4);
                bf16x8 xf[2], bfr[4];
#pragma unroll
                for (int tp = 0; tp < 2; ++tp) { const u32x4 q = *(const u32x4*)(XT + tr_off(hh * 64 + tp * 32 + r, k0));
                    u32x4 o; o.x = cvt_pk_bf16(bflo(q.x) * w0[0], bfhi(q.x) * w0[1]); o.y = cvt_pk_bf16(bflo(q.y) * w0[2], bfhi(q.y) * w0[3]);
                    o.z = cvt_pk_bf16(bflo(q.z) * w1[0], bfhi(q.z) * w1[1]); o.w = cvt_pk_bf16(bflo(q.w) * w1[2], bfhi(q.w) * w1[3]);
                    xf[tp] = __builtin_bit_cast(bf16x8, o); }
#pragma unroll
                for (int tn = 0; tn < 4; ++tn) bfr[tn] = *(const bf16x8*)(BT + tr_off(tn * 32 + r, k0));
#pragma unroll
                for (int tp = 0; tp < 2; ++tp)
#pragma unroll
                    for (int tn = 0; tn < 4; ++tn) acc[tp][tn] = MFMA32(bfr[tn], xf[tp], acc[tp][tn]);
            }
            bf16_t* sp = ST + ((size_t)(b * 2 + dir) * NSLOT + slot) * PLANE + (size_t)(g * 4 + hh) * 64 * 128;
            __syncthreads();
            char* Tw = lds + wave * 17408;
#pragma unroll
            for (int tp = 0; tp < 2; ++tp)
#pragma unroll
                for (int tn = 0; tn < 4; ++tn)
#pragma unroll
                    for (int q = 0; q < 4; ++q) { const f32x16& a = acc[tp][tn];
                        u32x2 w; w.x = cvt_pk_bf16(a[4 * q], a[4 * q + 1]); w.y = cvt_pk_bf16(a[4 * q + 2], a[4 * q + 3]);
                        *(u32x2*)(Tw + rm_off(tp * 32 + r, tn * 32 + 8 * q + 4 * h)) = w; }
            asm volatile("s_waitcnt lgkmcnt(0)" ::: "memory");
#pragma unroll 4
            for (int k = 0; k < 16; ++k) { const int row = k * 4 + (lane >> 4), col = (lane & 15) * 8;
                *(u32x4*)(sp + (size_t)row * 128 + col) = *(const u32x4*)(Tw + rm_off(row, col)); }
        }
    }
    SEAM(4);

    if (IN(5)) { PROBE_BEGIN(5); PHASE_VARS PHASE_PTRS
        const int gt = bid * NTHR + tid, ngt = G * NTHR;
        for (int it = gt; it < NB * 2 * 32 * 64 * 16; it += ngt) {
            const int e = (it & 32767) * 8, head = (it >> 10) & 31, bd = it >> 15, dir = bd & 1;
            bf16_t* base = ST + (size_t)bd * NSLOT * PLANE + e; const float* dec = DEC + (size_t)bd * NSLOT * 32 + head;
            float run[8] = {0.f, 0.f, 0.f, 0.f, 0.f, 0.f, 0.f, 0.f};
#pragma unroll
            for (int half = 0; half < 2; ++half) {
                u32x4 v[17]; float dc[17];
#pragma unroll
                for (int s = 0; s < 17; ++s) { const int step = half * 17 + s; const int slot = dir == 0 ? step : (step == 0 ? 1 : (step == 1 ? 0 : 35 - step));
                    v[s] = *(const u32x4*)(base + (size_t)slot * PLANE); dc[s] = dec[slot * 32]; }
#pragma unroll
                for (int s = 0; s < 17; ++s) { const int step = half * 17 + s; const int slot = dir == 0 ? step : (step == 0 ? 1 : (step == 1 ? 0 : 35 - step));
                    u32x4 o; o.x = cvt_pk_bf16(run[0], run[1]); o.y = cvt_pk_bf16(run[2], run[3]); o.z = cvt_pk_bf16(run[4], run[5]); o.w = cvt_pk_bf16(run[6], run[7]);
                    *(u32x4*)(base + (size_t)slot * PLANE) = o;
                    const float d = dc[s];
                    run[0] = d * run[0] + bflo(v[s].x); run[1] = d * run[1] + bfhi(v[s].x); run[2] = d * run[2] + bflo(v[s].y); run[3] = d * run[3] + bfhi(v[s].y);
                    run[4] = d * run[4] + bflo(v[s].z); run[5] = d * run[5] + bfhi(v[s].z); run[6] = d * run[6] + bflo(v[s].w); run[7] = d * run[7] + bfhi(v[s].w); }
            }
        }
    }
    SEAM(5);

    if (IN(6)) { PROBE_BEGIN(6); PHASE_VARS PHASE_PTRS
        char* Cs = lds;
        char* Bs = lds + 34816;
        char* XT = lds + 69632;
        char* Hf = lds + 87040;
        char* Hb = lds + 104448;
        float* fa = (float*)(lds + 121856);
        float* fb = (float*)(lds + 130048);
        const float* a_log = args.in[I_ALOG]; const float* d_skip = args.in[I_DSKIP];
        const int wave_u = __builtin_amdgcn_readfirstlane(wave);
        const int r = lane & 31, h = lane >> 5, tl = wave_u >> 1, tsb = (wave_u & 1) * 2;
        u32x4 px[2], phf[2], phb[2];
#define LOADXH(hd_) do { _Pragma("unroll") for (int i = 0; i < 2; ++i) { const int idx = tid + i * NTHR; \
            px[i] = *(const u32x4*)(XBC + (size_t)(row0 + (idx >> 3)) * 4096 + (hd_) * 64 + (idx & 7) * 8); \
            const size_t so = (size_t)slot * PLANE + (size_t)((hd_) * 64 + (idx >> 4)) * 128 + (idx & 15) * 8; \
            phf[i] = *(const u32x4*)(ST + (size_t)(b * 2 + 0) * NSLOT * PLANE + so); phb[i] = *(const u32x4*)(ST + (size_t)(b * 2 + 1) * NSLOT * PLANE + so); } } while (0)
#define WRITEXH() do { _Pragma("unroll") for (int i = 0; i < 2; ++i) { const int idx = tid + i * NTHR; const int l = idx >> 3, p0 = (idx & 7) * 8; const u32x4 q = px[i]; \
            const unsigned short e[8] = {(unsigned short)q.x, (unsigned short)(q.x >> 16), (unsigned short)q.y, (unsigned short)(q.y >> 16), (unsigned short)q.z, (unsigned short)(q.z >> 16), (unsigned short)q.w, (unsigned short)(q.w >> 16)}; \
            _Pragma("unroll") for (int j = 0; j < 8; ++j) *(unsigned short*)(XT + tr_off(p0 + j, l)) = e[j]; \
            *(u32x4*)(Hf + rm_off(idx >> 4, (idx & 15) * 8)) = phf[i]; *(u32x4*)(Hb + rm_off(idx >> 4, (idx & 15) * 8)) = phb[i]; } } while (0)
        for (int it = bid; it < NB * 32 * 8; it += G) {
            const int g = it & 7, c = (it >> 3) & 31, b = it >> 8, slot = c + 2; const int row0 = b * RPB + slot * 128;
            __syncthreads();
#pragma unroll
            for (int i = 0; i < 4; ++i) { const int idx = tid + i * NTHR, l = idx >> 4, n0 = (idx & 15) * 8; const bf16_t* rp = XBC + (size_t)(row0 + l) * 4096 + 2048 + g * 128 + n0;
                *(u32x4*)(Bs + rm_off(l, n0)) = *(const u32x4*)rp; *(u32x4*)(Cs + rm_off(l, n0)) = *(const u32x4*)(rp + 1024); }
#pragma unroll
            for (int i = 0; i < 2; ++i) { const int idx = tid + i * NTHR, hd = idx >> 7, l = idx & 127;
                fa[(hd >> 1) * 512 + 256 + (hd & 1) * 128 + l] = DT[(size_t)(row0 + l) * 64 + (hd & 1) * 32 + g * 4 + (hd >> 1)]; }
            LOADXH(g * 4); WRITEXH();
            __syncthreads();
            { const int hd = wave, hh = hd >> 1, dir = hd & 1; const float A = -__expf(a_log[dir * 32 + g * 4 + hh]) * 1.4426950408889634f;
              float le0, le1, tot, a0, a1; wave_scan128(fa + hh * 512 + 256 + dir * 128, lane, le0, le1, tot, a0, a1);
              const float c0 = (dir == 0 ? le0 : tot - le0 + a0) * A, c1 = (dir == 0 ? le1 : tot - le1 + a1) * A;
              *(f32x2*)(fa + hh * 512 + dir * 128 + 2 * lane) = (f32x2){c0, c1};
              *(f32x2*)(fb + hh * 256 + dir * 128 + 2 * lane) = (f32x2){c0 - __log2f(a0), c1 - __log2f(a1)}; }
            f32x16 ga[2] = {f32x16{}, f32x16{}};
#pragma unroll 2
            for (int ks = 0; ks < 8; ++ks) { const int k0 = ks * 16 + 8 * h;
                const bf16x8 cf = *(const bf16x8*)(Cs + rm_off(tl * 32 + r, k0));
#pragma unroll
                for (int t2 = 0; t2 < 2; ++t2) { const bf16x8 bf_ = *(const bf16x8*)(Bs + rm_off((tsb + t2) * 32 + r, k0)); ga[t2] = MFMA32(bf_, cf, ga[t2]); } }
            __syncthreads();
#pragma unroll 1
            for (int hh = 0; hh < 4; ++hh) {
                const int head = g * 4 + hh; const float* fh = fa + hh * 512;
                if (hh < 3) LOADXH(head + 1);
                { const int l = tl * 32 + r; const float cfl = fh[l], rcl = fh[128 + l]; const float* fbh = fb + hh * 256;
#pragma unroll
                  for (int t2 = 0; t2 < 2; ++t2) { const int ts = tsb + t2;
                    if (ts < tl) {
#pragma unroll
                        for (int q = 0; q < 4; ++q) { const int s0 = ts * 32 + 8 * q + 4 * h; const f32x4 cs = *(const f32x4*)(fbh + s0);
                            u32x2 w; w.x = cvt_pk_bf16(ga[t2][4 * q] * __builtin_amdgcn_exp2f(cfl - cs[0]), ga[t2][4 * q + 1] * __builtin_amdgcn_exp2f(cfl - cs[1]));
                            w.y = cvt_pk_bf16(ga[t2][4 * q + 2] * __builtin_amdgcn_exp2f(cfl - cs[2]), ga[t2][4 * q + 3] * __builtin_amdgcn_exp2f(cfl - cs[3]));
                            *(u32x2*)(Bs + rm_off(l, s0)) = w; }
                    } else if (ts > tl) {
#pragma unroll
                        for (int q = 0; q < 4; ++q) { const int s0 = ts * 32 + 8 * q + 4 * h; const f32x4 cs = *(const f32x4*)(fbh + 128 + s0);
                            u32x2 w; w.x = cvt_pk_bf16(ga[t2][4 * q] * __builtin_amdgcn_exp2f(rcl - cs[0]), ga[t2][4 * q + 1] * __builtin_amdgcn_exp2f(rcl - cs[1]));
                            w.y = cvt_pk_bf16(ga[t2][4 * q + 2] * __builtin_amdgcn_exp2f(rcl - cs[2]), ga[t2][4 * q + 3] * __builtin_amdgcn_exp2f(rcl - cs[3]));
                            *(u32x2*)(Bs + rm_off(l, s0)) = w; }
                    } else {
                        const float dsk = d_skip[head];
#pragma unroll
                        for (int q = 0; q < 4; ++q) { const int s0 = ts * 32 + 8 * q + 4 * h;
                            const f32x4 cfs = *(const f32x4*)(fbh + s0), rcs = *(const f32x4*)(fbh + 128 + s0);
                            float m[4];
#pragma unroll
                            for (int j = 0; j < 4; ++j) { const int s = s0 + j;
                                const float wf = s <= l ? __builtin_amdgcn_exp2f(cfl - cfs[j]) : 0.f;
                                const float wb = s >= l ? __builtin_amdgcn_exp2f(rcl - rcs[j]) : 0.f;
                                m[j] = ga[t2][4 * q + j] * (wf + wb) + (s == l ? dsk : 0.f); }
                            u32x2 w; w.x = cvt_pk_bf16(m[0], m[1]); w.y = cvt_pk_bf16(m[2], m[3]);
                            *(u32x2*)(Bs + rm_off(l, s0)) = w; }
                    } } }
                __syncthreads();
                {
                    const int tp = wave & 1;
                    f32x16 aD = f32x16{}, aF = f32x16{}, aB = f32x16{};
#pragma unroll 2
                    for (int ks = 0; ks < 8; ++ks) { const int k0 = ks * 16 + 8 * h;
                        const bf16x8 mf = *(const bf16x8*)(Bs + rm_off(tl * 32 + r, k0)), xf = *(const bf16x8*)(XT + tr_off(tp * 32 + r, k0));
                        const bf16x8 cf = *(const bf16x8*)(Cs + rm_off(tl * 32 + r, k0)), hf = *(const bf16x8*)(Hf + rm_off(tp * 32 + r, k0)), hb = *(const bf16x8*)(Hb + rm_off(tp * 32 + r, k0));
                        aD = MFMA32(mf, xf, aD); aF = MFMA32(cf, hf, aF); aB = MFMA32(cf, hb, aB); }
                    bf16_t* yp = P + (size_t)row0 * LDP + C_XBC + head * 64 + tp * 32 + r;
#pragma unroll
                    for (int i = 0; i < 16; ++i) { const int l = tl * 32 + att::crow(i, h);
                        const float y = aD[i] + __builtin_amdgcn_exp2f(fh[l]) * aF[i] + __builtin_amdgcn_exp2f(fh[128 + l]) * aB[i];
                        yp[(size_t)l * LDP] = f2bf(y); }
                }
                __syncthreads();
                if (hh < 3) WRITEXH();
            }
        }
#undef LOADXH
#undef WRITEXH
    }
    PROBE_END(6);
    if (IN(6) && IN(13)) { PROBE_BEGIN(13); PHASE_VARS PHASE_PTRS
        for (int u = bid; u < 512; u += G) {
            const int b = u >> 8, w = u & 255, xcd = w & 7, j = w >> 3, kvh = xcd >> 1, idx = (xcd & 1) * 32 + j, rep = idx >> 4, qb = idx & 15, head = kvh * 4 + rep;
            bf16_t* Qb = P + (size_t)(b * RPB + CTXL + qb * 256) * LDP + C_Q + head * 128;
            const bf16_t* Kh = P + (size_t)(b * RPB) * LDP + C_K + kvh * 128; const bf16_t* Vh = P + (size_t)(b * RPB) * LDP + C_V + kvh * 128;
            att::attn_dense_body(Qb, Kh, Vh, Qb, RPB, lds, tid, args.in[I_QN], qb * 256);
            __syncthreads();
        }
    }
    PROBE_END(13);
    do { if (IN(6) && IN(7)) xcd_barrier(xbar, wave_s == 0 && __builtin_amdgcn_mbcnt_hi(~0u, __builtin_amdgcn_mbcnt_lo(~0u, 0u)) == 0u); } while (0);

    if (IN(7)) { PROBE_BEGIN(7); PHASE_VARS PHASE_PTRS
        const float* ssmn = args.in[I_SSMN];
        for (int lr = gw; lr < ML; lr += ngw) {
            const int b = lr >> 12, t = lr & 4095; bf16_t* rowp = P + (size_t)(b * RPB + CTXL + t) * LDP;
            u32x2 yv[8], zv[8]; f32x4 nwv[8]; u32x2 ov[8];
#pragma unroll
            for (int g = 0; g < 8; ++g) { yv[g] = *(const u32x2*)(rowp + C_XBC + g * 256 + lane * 4); zv[g] = *(const u32x2*)(rowp + C_Z + g * 256 + lane * 4); nwv[g] = *(const f32x4*)(ssmn + g * 256 + lane * 4); }
            float vv[8][4], ssg[8];
#pragma unroll
            for (int g = 0; g < 8; ++g) {
                vv[g][0] = bflo(yv[g].x) * siluf_(bflo(zv[g].x)); vv[g][1] = bfhi(yv[g].x) * siluf_(bfhi(zv[g].x)); vv[g][2] = bflo(yv[g].y) * siluf_(bflo(zv[g].y)); vv[g][3] = bfhi(yv[g].y) * siluf_(bfhi(zv[g].y));
                ssg[g] = vv[g][0] * vv[g][0] + vv[g][1] * vv[g][1] + vv[g][2] * vv[g][2] + vv[g][3] * vv[g][3]; }
#pragma unroll
            for (int o = 32; o >= 1; o >>= 1) {
#pragma unroll
                for (int g = 0; g < 8; ++g) ssg[g] += __shfl_xor(ssg[g], o); }
#pragma unroll
            for (int g = 0; g < 8; ++g) { const float rstd = rsqrtf(ssg[g] * (1.f / 256.f) + EPS);
                ov[g].x = cvt_pk_bf16(vv[g][0] * rstd * nwv[g][0], vv[g][1] * rstd * nwv[g][1]); ov[g].y = cvt_pk_bf16(vv[g][2] * rstd * nwv[g][2], vv[g][3] * rstd * nwv[g][3]); }
#pragma unroll
            for (int g = 0; g < 8; ++g) *(u32x2*)(rowp + C_Z + g * 256 + lane * 4) = ov[g];
        }
        __syncthreads();
        char* scr = lds + wave * 8448;
        transpose_matrix(args.in[I_WF1], DM, 2 * DFF, (bf16_t*)(ws + WS_WF1), 2 * DFF, [](int db) { const int pn = db >> 2, q = db & 3; return q < 2 ? pn * 128 + q * 64 : DFF + pn * 128 + (q - 2) * 64; }, scr, gw, ngw, lane);
        __syncthreads();
    }
    SEAM(7);

    if (IN(8)) { PROBE_BEGIN(8); PHASE_VARS PHASE_PTRS
        pg8::Sched S; S.init(32, 8, G, bid, 3);
        pg8::Gemm g{P + C_Z, (const bf16_t*)(ws + WS_WSSM), LDP, DM, DM, (size_t)(C_Q - C_Z) * 2};
        pg8::EpiMerge E{P};
        pg8::gemm_phase<pg8::EpiMerge>((LAS unsigned char*)lds_raw, g, S, E, tid);
    }
    SEAM(8);

    if (IN(9)) { PROBE_BEGIN(9); PHASE_VARS PHASE_PTRS
        pg8::Sched S; S.init(32, 8, G, bid, 1);
        pg8::Gemm g{P + C_G, (const bf16_t*)(ws + WS_WO), LDP, DM, DM};
        pg8::EpiResid<0> E{x, args.out, MOD, b_mod, 2 * DM};
        pg8::gemm_phase<pg8::EpiResid<0>>((LAS unsigned char*)lds_raw, g, S, E, tid);
    }
    SEAM(9);

    if (IN(10)) { PROBE_BEGIN(10); PHASE_VARS PHASE_PTRS
        bf16_t* XN2 = (bf16_t*)(ws + WS_XN2); const float* norm2 = args.in[I_NORM2];
        float* pl = (float*)lds;
        const int rpb = (ML + G - 1) / G;
        for (int r0 = bid * rpb; r0 < ML; r0 += G * rpb) {
            const int b = r0 >> 12;
            __syncthreads();
            for (int i = tid; i < DM; i += NTHR) { const float* mv = MOD + (size_t)b * NMOD;
                pl[i] = norm2[i] * (mv[4 * DM + i] + b_mod[4 * DM + i] + 1.f); pl[2048 + i] = mv[3 * DM + i] + b_mod[3 * DM + i]; }
            __syncthreads();
            const int rend = (r0 + rpb < ML) ? r0 + rpb : ML;
            for (int r = r0 + wave; r < rend; r += NWAVES) {
                const int rb = r >> 12; const float* src = args.out + (size_t)r * DM;
                f32x4 xv[8]; float ss = 0.f;
#pragma unroll
                for (int j = 0; j < 8; ++j) xv[j] = *(const f32x4*)(src + j * 256 + lane * 4);
#pragma unroll
                for (int j = 0; j < 8; ++j) ss += xv[j][0] * xv[j][0] + xv[j][1] * xv[j][1] + xv[j][2] * xv[j][2] + xv[j][3] * xv[j][3];
                const float rstd = rsqrtf(wave_sum(ss) * (1.f / DM) + EPS);
                if (rb == b) {
#pragma unroll
                    for (int j = 0; j < 8; ++j) { const int col = j * 256 + lane * 4;
                        const f32x4 o = xv[j] * rstd * *(const f32x4*)(pl + col) + *(const f32x4*)(pl + 2048 + col);
                        u32x2 w; w.x = cvt_pk_bf16(o[0], o[1]); w.y = cvt_pk_bf16(o[2], o[3]);
                        *(u32x2*)(XN2 + (size_t)r * DM + col) = w; }
                } else {
                    const float* mv = MOD + (size_t)rb * NMOD;
#pragma unroll
                    for (int j = 0; j < 8; ++j) { const int col = j * 256 + lane * 4;
                        const f32x4 nw = *(const f32x4*)(norm2 + col), sh = *(const f32x4*)(mv + 3 * DM + col) + *(const f32x4*)(b_mod + 3 * DM + col), sc = *(const f32x4*)(mv + 4 * DM + col) + *(const f32x4*)(b_mod + 4 * DM + col);
                        const f32x4 o = xv[j] * rstd * nw * (sc + 1.f) + sh;
                        u32x2 w; w.x = cvt_pk_bf16(o[0], o[1]); w.y = cvt_pk_bf16(o[2], o[3]);
                        *(u32x2*)(XN2 + (size_t)r * DM + col) = w; }
                }
            }
        }
    }
    SEAM(10);

    if (IN(11)) { PROBE_BEGIN(11); PHASE_VARS PHASE_PTRS
        pg8::Sched S; S.init(32, 44, G, bid, 0);
        pg8::Gemm g{(const bf16_t*)(ws + WS_XN2), (const bf16_t*)(ws + WS_WF1), DM, DM, DM};
        pg8::EpiSwiglu E{(bf16_t*)(ws + WS_HID)};
        pg8::gemm_phase<pg8::EpiSwiglu>((LAS unsigned char*)lds_raw, g, S, E, tid);
        {
            const int rounds = (S.total + G - 1) / G, last_cnt = S.total - (rounds - 1) * G, n_idle = G - last_cnt;
            const bool idle = n_idle > 0 ? (bid >= last_cnt) : true;
            if (idle) {
                const int gwi = n_idle > 0 ? (bid - last_cnt) * NWAVES + wave : gw, ngwi = n_idle > 0 ? n_idle * NWAVES : ngw;
                char* scr = lds + wave * 8448;
                transpose_matrix(args.in[I_WF2], DFF, DM, (bf16_t*)(ws + WS_WF2), DM, [](int db) { return db * 64; }, scr, gwi, ngwi, lane);
            }
        }
    }
    SEAM(11);

    if (IN(12)) { PROBE_BEGIN(12); PHASE_VARS PHASE_PTRS
        pg8::Sched S; S.init(32, 8, G, bid, 0);
        pg8::Gemm g{(const bf16_t*)(ws + WS_HID), (const bf16_t*)(ws + WS_WF2), DFF, DFF, DFF};
        pg8::EpiResid<1> E{args.out, args.out, MOD, b_mod, 5 * DM};
        pg8::gemm_phase<pg8::EpiResid<1>>((LAS unsigned char*)lds_raw, g, S, E, tid);
    }
    if (PROBE_MASK != 0 && bid == 0 && threadIdx.x == 0) { const unsigned t0 = (unsigned)__builtin_amdgcn_s_memrealtime(), wait = misc[3] * (unsigned)PROBE_MULT;
        while ((unsigned)__builtin_amdgcn_s_memrealtime() - t0 < wait) __builtin_amdgcn_s_sleep(8); }
#undef IN
#undef SEAM
}

constexpr int N_PHASES = 13;
#ifndef MK_PER_PHASE
#define MK_PER_PHASE 0
#endif
extern "C" void kernel_launch(void* const* d_in, const int* in_sizes, int n_in, void* d_out, int out_size, void* d_ws, size_t ws_size, hipStream_t stream) {
    static int grid = 0;
    if (grid == 0) {
        if (n_in != 22 || out_size != ML * DM || ws_size < WS_END) { fprintf(stderr, "kernel_launch: bad shapes n_in %d out %d ws %zu (need %zu)\n", n_in, out_size, ws_size, (size_t)WS_END); grid = -1; return; }
        int dev = 0, cus = 0, per_cu = 0;
        if (hipGetDevice(&dev) != hipSuccess || hipDeviceGetAttribute(&cus, hipDeviceAttributeMultiprocessorCount, dev) != hipSuccess) { grid = -1; return; }
        if (hipFuncSetAttribute((const void*)fwd_megakernel, hipFuncAttributeMaxDynamicSharedMemorySize, LDS_BYTES) != hipSuccess) { fprintf(stderr, "kernel_launch: hipFuncSetAttribute failed\n"); grid = -1; return; }
        if (hipOccupancyMaxActiveBlocksPerMultiprocessor(&per_cu, (const void*)fwd_megakernel, NTHR, LDS_BYTES) != hipSuccess || per_cu < 1) { fprintf(stderr, "kernel_launch: occupancy query says %d\n", per_cu); (void)hipGetLastError(); per_cu = 1; }
        grid = cus;
    }
    if (grid < 0) return;
    (void)hipMemsetAsync((char*)d_ws, 0, ZERO_BYTES, stream);
    Args a{};
    for (int i = 0; i < 22; ++i) a.in[i] = (const float*)d_in[i];
    a.out = (float*)d_out; a.ws = (unsigned char*)d_ws;
#if MK_PER_PHASE
    for (int p = 0; p < N_PHASES; ++p) { a.ph_lo = p; a.ph_hi = p + 1; hipLaunchKernelGGL(fwd_megakernel, dim3(grid), dim3(NTHR), LDS_BYTES, stream, a); }
#else
    a.ph_lo = 0; a.ph_hi = N_PHASES;
    void* kargs[] = {&a};
    hipError_t e = hipLaunchCooperativeKernel((const void*)fwd_megakernel, dim3(grid), dim3(NTHR), kargs, LDS_BYTES, stream);
    if (e != hipSuccess) fprintf(stderr, "kernel_launch: cooperative launch failed: %s (grid %d)\n", hipGetErrorString(e), grid);
#endif
}
```
